# Optimizing an MI355X kernel written in HIP

```python
import jax, jax.numpy as jnp
from jax import lax
import numpy as np

D_MODEL = 1024
BATCH = 4
SEQ = 8192
DEPTH = 2

D_FF = 2816
FFN_HALF = 0.5
N_HEADS = 8
Q_LORA = 352
KV_LORA = 128
QK_NOPE = 64
QK_ROPE = 32
V_HEAD = 64
ROPE_THETA = 10000.0
Q_BLOCK = 128
CONV_CH = 256
CONV_WIDTH = 31
POOL_WINDOWS = (2, 4, 8, 16)
POOL_GROUPS = 4
POOL_GC = 128
FNET_GROUPS = 4
FNET_GC = 128
N_BRANCH = 4
W_A = Q_LORA + KV_LORA + QK_ROPE
W_B = 2 * CONV_CH
W_C = POOL_GROUPS * POOL_GC
W_D = FNET_GROUPS * FNET_GC
W_MIX = W_A + W_B + W_C + W_D
W_IN = W_MIX + N_BRANCH * D_MODEL
N_SUB = 3
N_MOD = 3 * N_SUB
EPS = 1e-6

kernel_name = "hybrid_gated_mla_conv_pool_fnet_encoder"


def rmsnorm(x, g):
    x32 = x.astype(jnp.float32)
    y = x32 * lax.rsqrt(jnp.mean(x32 * x32, axis=-1, keepdims=True) + EPS)
    return (y * g.astype(jnp.float32)).astype(x.dtype)


def layernorm(x, g, b):
    x32 = x.astype(jnp.float32)
    mu = jnp.mean(x32, axis=-1, keepdims=True)
    xc = x32 - mu
    y = xc * lax.rsqrt(jnp.mean(xc * xc, axis=-1, keepdims=True) + EPS)
    return (y * g.astype(jnp.float32) + b.astype(jnp.float32)).astype(x.dtype)


def modulate(h, shift, scale):
    return h * (1 + scale[:, None, :]) + shift[:, None, :]


def swiglu(h, w_in, w_out):
    gu = h @ w_in
    g, u = jnp.split(gu, 2, axis=-1)
    return (jax.nn.silu(g) * u) @ w_out


def rope_tables(seq, dim):
    pos = jnp.arange(seq, dtype=jnp.float32)
    inv = ROPE_THETA ** (-jnp.arange(0, dim, 2, dtype=jnp.float32) / dim)
    ang = pos[:, None] * inv[None, :]
    return jnp.cos(ang), jnp.sin(ang)


def apply_rope(x, cos, sin):
    x1, x2 = jnp.split(x, 2, axis=-1)
    c = cos.astype(x.dtype)
    s = sin.astype(x.dtype)
    return jnp.concatenate([x1 * c - x2 * s, x1 * s + x2 * c], axis=-1)


def dense_attention(q, k, v):
    B, S, H, Dq = q.shape
    nb = S // Q_BLOCK
    qb = q.reshape(B, nb, Q_BLOCK, H, Dq).transpose(1, 0, 2, 3, 4)
    sm_scale = Dq ** -0.5

    def one_block(qblk):
        s = jnp.einsum('bqhd,bkhd->bhqk', qblk, k).astype(jnp.float32) * sm_scale
        p = jax.nn.softmax(s, axis=-1).astype(v.dtype)
        return jnp.einsum('bhqk,bkhd->bqhd', p, v)

    o = lax.map(one_block, qb)
    return o.transpose(1, 0, 2, 3, 4).reshape(B, S, H, v.shape[-1])


def mla_mixer(za, q_norm_g, w_uq, kv_norm_g, w_ukv, w_a):
    B, S, _ = za.shape
    cq = za[..., :Q_LORA]
    ckv = za[..., Q_LORA:Q_LORA + KV_LORA]
    kr = za[..., Q_LORA + KV_LORA:]
    cos, sin = rope_tables(S, QK_ROPE)
    q = (rmsnorm(cq, q_norm_g) @ w_uq).reshape(B, S, N_HEADS, QK_NOPE + QK_ROPE)
    q_nope, q_rope = q[..., :QK_NOPE], q[..., QK_NOPE:]
    q_rope = apply_rope(q_rope, cos[:, None, :], sin[:, None, :])
    kv = (rmsnorm(ckv, kv_norm_g) @ w_ukv).reshape(B, S, N_HEADS, QK_NOPE + V_HEAD)
    k_nope, v = kv[..., :QK_NOPE], kv[..., QK_NOPE:]
    k_rope = apply_rope(kr, cos, sin)
    k_rope = jnp.broadcast_to(k_rope[:, :, None, :], (B, S, N_HEADS, QK_ROPE))
    qf = jnp.concatenate([q_nope, q_rope], axis=-1)
    kf = jnp.concatenate([k_nope, k_rope], axis=-1)
    o = dense_attention(qf, kf, v).reshape(B, S, N_HEADS * V_HEAD)
    return o @ w_a


def conv_mixer(zb, conv_w, conv_b, ln_g, ln_b, w_b):
    a, gt = jnp.split(zb, 2, axis=-1)
    u = a * jax.nn.sigmoid(gt)
    pad = CONV_WIDTH // 2
    y = lax.conv_general_dilated(
        u, conv_w[:, None, :].astype(u.dtype), window_strides=(1,), padding=[(pad, pad)],
        dimension_numbers=('NWC', 'WIO', 'NWC'), feature_group_count=CONV_CH) + conv_b
    y = jax.nn.silu(layernorm(y, ln_g, ln_b))
    return y @ w_b


def pool_mixer(zc, pool_w, pool_scale, w_c):
    B, S, _ = zc.shape
    ug = zc.reshape(B, S, POOL_GROUPS, POOL_GC)
    cs = jnp.cumsum(ug.astype(jnp.float32), axis=1)
    cs = jnp.pad(cs, ((0, 0), (1, 0), (0, 0), (0, 0)))
    t = jnp.arange(S)
    means = []
    for g, w in enumerate(POOL_WINDOWS):
        lo = w // 2
        hi = w - 1 - lo
        start = jnp.clip(t - lo, 0, S)
        end = jnp.clip(t + hi + 1, 0, S)
        win = cs[:, end, g] - cs[:, start, g]
        cnt = (end - start).astype(jnp.float32)[None, :, None]
        means.append(win / cnt)
    mean = jnp.stack(means, axis=2)
    d = (mean - ug.astype(jnp.float32)).astype(zc.dtype)
    y = jnp.einsum('bsgc,gcd->bsgd', d, pool_w).reshape(B, S, W_C) * pool_scale
    return y @ w_c


def fourier_mixer(zd, w_d):
    B, S, _ = zd.shape
    v = zd.astype(jnp.float32).reshape(B, S, FNET_GROUPS, FNET_GC)
    f = jnp.fft.fft2(v, axes=(1, 3), norm='ortho').real
    return f.astype(zd.dtype).reshape(B, S, W_D) @ w_d


def token_mixer(h, w_in, q_norm_g, w_uq, kv_norm_g, w_ukv, w_a, conv_w, conv_b,
                conv_ln_g, conv_ln_b, w_b, pool_w, pool_scale, w_c, w_d, w_out):
    B, S, D = h.shape
    z = h @ w_in
    za = z[..., :W_A]
    zb = z[..., W_A:W_A + W_B]
    zc = z[..., W_A + W_B:W_A + W_B + W_C]
    zd = z[..., W_A + W_B + W_C:W_MIX]
    gates = jax.nn.sigmoid(z[..., W_MIX:]).reshape(B, S, N_BRANCH, D)
    y_a = mla_mixer(za, q_norm_g, w_uq, kv_norm_g, w_ukv, w_a)
    y_b = conv_mixer(zb, conv_w, conv_b, conv_ln_g, conv_ln_b, w_b)
    y_c = pool_mixer(zc, pool_w, pool_scale, w_c)
    y_d = fourier_mixer(zd, w_d)
    merged = (gates[:, :, 0] * y_a + gates[:, :, 1] * y_b
              + gates[:, :, 2] * y_c + gates[:, :, 3] * y_d)
    return merged @ w_out


def setup_inputs(seed: int = 0) -> dict:
    key = jax.random.key(seed)
    ks = jax.random.split(key, 32)
    f32 = jnp.float32
    L, D = DEPTH, D_MODEL

    def nrm(k, shape, scale):
        return jax.random.normal(k, shape, f32) * scale

    return {
        "x": nrm(ks[0], (BATCH, SEQ, D), 1.0),
        "c": nrm(ks[1], (BATCH, D), 1.0),
        "ada_w": nrm(ks[2], (L, D, N_MOD * D), 0.5 * D ** -0.5),
        "ada_b": nrm(ks[3], (L, N_MOD * D), 0.02),
        "norm_g": 1.0 + nrm(ks[4], (L, 2 * N_SUB, D), 0.02),
        "ffn1_w_in": nrm(ks[5], (L, D, 2 * D_FF), D ** -0.5),
        "ffn1_w_out": nrm(ks[6], (L, D_FF, D), D_FF ** -0.5),
        "ffn2_w_in": nrm(ks[7], (L, D, 2 * D_FF), D ** -0.5),
        "ffn2_w_out": nrm(ks[8], (L, D_FF, D), D_FF ** -0.5),
        "w_in": nrm(ks[9], (L, D, W_IN), D ** -0.5),
        "q_norm_g": 1.0 + nrm(ks[10], (L, Q_LORA), 0.02),
        "w_uq": nrm(ks[11], (L, Q_LORA, N_HEADS * (QK_NOPE + QK_ROPE)), Q_LORA ** -0.5),
        "kv_norm_g": 1.0 + nrm(ks[12], (L, KV_LORA), 0.02),
        "w_ukv": nrm(ks[13], (L, KV_LORA, N_HEADS * (QK_NOPE + V_HEAD)), KV_LORA ** -0.5),
        "w_a": nrm(ks[14], (L, N_HEADS * V_HEAD, D), (N_HEADS * V_HEAD) ** -0.5),
        "conv_w": nrm(ks[15], (L, CONV_WIDTH, CONV_CH), CONV_WIDTH ** -0.5),
        "conv_b": nrm(ks[16], (L, CONV_CH), 0.02),
        "conv_ln_g": 1.0 + nrm(ks[17], (L, CONV_CH), 0.02),
        "conv_ln_b": nrm(ks[18], (L, CONV_CH), 0.02),
        "w_b": nrm(ks[19], (L, CONV_CH, D), CONV_CH ** -0.5),
        "pool_w": nrm(ks[20], (L, POOL_GROUPS, POOL_GC, POOL_GC), POOL_GC ** -0.5),
        "pool_scale": 1.0 + nrm(ks[21], (L, W_C), 0.1),
        "w_c": nrm(ks[22], (L, W_C, D), W_C ** -0.5),
        "w_d": nrm(ks[23], (L, W_D, D), W_D ** -0.5),
        "w_out": nrm(ks[24], (L, D, D), D ** -0.5),
    }


def reference(x, c, ada_w, ada_b, norm_g, ffn1_w_in, ffn1_w_out, ffn2_w_in, ffn2_w_out,
              w_in, q_norm_g, w_uq, kv_norm_g, w_ukv, w_a, conv_w, conv_b, conv_ln_g,
              conv_ln_b, w_b, pool_w, pool_scale, w_c, w_d, w_out):
    B = x.shape[0]
    c_act = jax.nn.silu(c)
    for l in range(DEPTH):
        mod = (c_act @ ada_w[l] + ada_b[l]).reshape(B, N_MOD, D_MODEL)
        h = modulate(rmsnorm(x, norm_g[l, 0]), mod[:, 0], mod[:, 1])
        y = rmsnorm(swiglu(h, ffn1_w_in[l], ffn1_w_out[l]), norm_g[l, 1])
        x = x + FFN_HALF * mod[:, 2][:, None, :] * y
        h = modulate(rmsnorm(x, norm_g[l, 2]), mod[:, 3], mod[:, 4])
        y = token_mixer(h, w_in[l], q_norm_g[l], w_uq[l], kv_norm_g[l], w_ukv[l], w_a[l],
                        conv_w[l], conv_b[l], conv_ln_g[l], conv_ln_b[l], w_b[l],
                        pool_w[l], pool_scale[l], w_c[l], w_d[l], w_out[l])
        x = x + mod[:, 5][:, None, :] * rmsnorm(y, norm_g[l, 3])
        h = modulate(rmsnorm(x, norm_g[l, 4]), mod[:, 6], mod[:, 7])
        y = rmsnorm(swiglu(h, ffn2_w_in[l], ffn2_w_out[l]), norm_g[l, 5])
        x = x + FFN_HALF * mod[:, 8][:, None, :] * y
    return x
```

```cpp
#include <hip/hip_runtime.h>
#include <hip/hip_cooperative_groups.h>
#include <cstdio>
#include <cstdint>
namespace cg = cooperative_groups;
#ifndef DBG_MASK
#define DBG_MASK 0
#endif
namespace pg8 {
#define PG8_LAS __attribute__((address_space(3)))
typedef unsigned short bf16_t;
typedef short bf16x8 __attribute__((ext_vector_type(8)));
typedef float f32x4 __attribute__((ext_vector_type(4)));
typedef unsigned u32x4 __attribute__((ext_vector_type(4)));
constexpr int BM = 256, BK = 64, HALF = 128, HTB = HALF * BK * 2  , STAGE_BYTES = 8 * HTB, NXCD = 8, WGM = 8;

__host__ __device__ __forceinline__ int lds_byte(int r, int c) { const int st = (r >> 4) * 2 + (c >> 5), rr = r & 15, cc = c & 31, ob = rr * 64 + cc * 2; return st * 1024 + (ob ^ (((ob >> 9) & 1) << 5)); }
__host__ __device__ __forceinline__ void stage_rc(int b, int& R, int& C) { const int st = b / 1024, sb = b % 1024, swz = sb ^ (((sb >> 9) & 1) << 5); R = (st >> 1) * 16 + swz / 64; C = (st & 1) * 32 + (swz % 64) / 2; }
__host__ __device__ __forceinline__ int perm32(int rho) { const int n = rho >> 4, i = rho & 15; return 8 * (i >> 2) + 4 * n + (i & 3); }

struct Unit { int pm, pn; };
struct Gemm { const bf16_t* A; const bf16_t* Bt; int M, N, K; };

struct StaticOrder {
    int nM, nN, nwg, G, c;
    __host__ __device__ void init(int M, int N, int G_, int c_) { nM = M / BM; nN = N / BM; nwg = nM * nN; G = G_; c = c_; }
    __host__ __device__ bool next(int i, Unit& u) const {
        const long L = (long)i * G + c; if (L >= nwg) return false;
        int wgid = (int)L; { const int q = nwg / NXCD, r = nwg % NXCD, xcd = wgid % NXCD, off = wgid / NXCD; wgid = (xcd < r ? xcd * (q + 1) : r * (q + 1) + (xcd - r) * q) + off; }
        const int nig = WGM * nN, gid = wgid / nig, fm = gid * WGM, gsz = (nM - fm) < WGM ? (nM - fm) : WGM;
        u.pm = fm + ((wgid % nig) % gsz); u.pn = (wgid % nig) / gsz; return true;
    }
    __device__ __forceinline__ void a_ready(const Unit&) const {}
    __device__ __forceinline__ void done(const Unit&) const {}
};

typedef float f32x2_t __attribute__((ext_vector_type(2))); typedef __bf16 bf16x2_t __attribute__((ext_vector_type(2)));
typedef unsigned u32x2 __attribute__((ext_vector_type(2)));
__device__ __forceinline__ unsigned pk2(float lo, float hi) { f32x2_t v = {lo, hi}; bf16x2_t b = __builtin_convertvector(v, bf16x2_t); return __builtin_bit_cast(unsigned, b); }
__device__ __forceinline__ u32x4 pack8(f32x4 a, f32x4 b) { u32x4 w; w.x = pk2(a[0], a[1]); w.y = pk2(a[2], a[3]); w.z = pk2(b[0], b[1]); w.w = pk2(b[2], b[3]); return w; }
__device__ __forceinline__ u32x2 pack4(f32x4 a) { u32x2 w; w.x = pk2(a[0], a[1]); w.y = pk2(a[2], a[3]); return w; }
__device__ __forceinline__ float bflo(unsigned u) { return __uint_as_float(u << 16); }
__device__ __forceinline__ float bfhi(unsigned u) { return __uint_as_float(u & 0xffff0000u); }
__device__ __forceinline__ float sigm(float x) { return __builtin_amdgcn_rcpf(1.0f + __expf(-x)); }
__device__ __forceinline__ f32x4 sigm4(f32x4 v) { f32x4 o; o[0] = sigm(v[0]); o[1] = sigm(v[1]); o[2] = sigm(v[2]); o[3] = sigm(v[3]); return o; }

struct EpiPlain {
    static constexpr bool PERM = true, AFTER_DRAIN = false;
    bf16_t* O; int ldc;
    __device__ __forceinline__ void operator()(const f32x4 (&acc)[2][2][4][2], const Unit& u, int wr, int wc, int fr, int fq) const {
        const int row0 = u.pm * BM + wr * 64 + fr, col0 = u.pn * BM + wc * 32 + 8 * fq;
#pragma unroll
        for (int ai = 0; ai < 2; ++ai)
#pragma unroll
            for (int m = 0; m < 4; ++m) { asm volatile("" ::: "memory"); bf16_t* rowp = O + (size_t)(row0 + ai * HALF + m * 16) * ldc + col0;
#pragma unroll
                for (int bj = 0; bj < 2; ++bj) *(u32x4*)(rowp + bj * HALF) = pack8(acc[ai][bj][m][0], acc[ai][bj][m][1]); }
    }
};
struct EpiSigm {
    static constexpr bool PERM = true, AFTER_DRAIN = false;
    bf16_t* O; int ldc;
    __device__ __forceinline__ void operator()(const f32x4 (&acc)[2][2][4][2], const Unit& u, int wr, int wc, int fr, int fq) const {
        const int row0 = u.pm * BM + wr * 64 + fr, col0 = u.pn * BM + wc * 32 + 8 * fq;
#pragma unroll
        for (int ai = 0; ai < 2; ++ai)
#pragma unroll
            for (int m = 0; m < 4; ++m) { asm volatile("" ::: "memory"); bf16_t* rowp = O + (size_t)(row0 + ai * HALF + m * 16) * ldc + col0;
#pragma unroll
                for (int bj = 0; bj < 2; ++bj) *(u32x4*)(rowp + bj * HALF) = pack8(sigm4(acc[ai][bj][m][0]), sigm4(acc[ai][bj][m][1])); }
    }
};
struct EpiSwiglu {
    static constexpr bool PERM = true, AFTER_DRAIN = false;
    bf16_t* O; int ldc;
    __device__ __forceinline__ void operator()(const f32x4 (&acc)[2][2][4][2], const Unit& u, int wr, int wc, int fr, int fq) const {
        const int row0 = u.pm * BM + wr * 64 + fr, col0 = u.pn * HALF + wc * 32 + 8 * fq;
#pragma unroll
        for (int ai = 0; ai < 2; ++ai)
#pragma unroll
            for (int m = 0; m < 4; ++m) { asm volatile("" ::: "memory"); bf16_t* rowp = O + (size_t)(row0 + ai * HALF + m * 16) * ldc + col0;
                const f32x4 g0 = acc[ai][0][m][0], g1 = acc[ai][0][m][1], u0 = acc[ai][1][m][0], u1 = acc[ai][1][m][1];
                *(u32x4*)rowp = pack8(g0 * sigm4(g0) * u0, g1 * sigm4(g1) * u1); }
    }
};
struct EpiMixA {
    static constexpr bool PERM = true, AFTER_DRAIN = false;
    bf16_t *ZA, *U, *ZC, *ZD;
    __device__ __forceinline__ void operator()(const f32x4 (&acc)[2][2][4][2], const Unit& u, int wr, int wc, int fr, int fq) const {
        const int row0 = u.pm * BM + wr * 64 + fr, cw = wc * 32 + 8 * fq; const int pn = u.pn;
#pragma unroll
        for (int ai = 0; ai < 2; ++ai)
#pragma unroll
            for (int m = 0; m < 4; ++m) { asm volatile("" ::: "memory"); const int row = row0 + ai * HALF + m * 16;
                if (pn < 2) { bf16_t* p = ZA + (size_t)row * 512 + pn * 256 + cw;
                    *(u32x4*)p = pack8(acc[ai][0][m][0], acc[ai][0][m][1]); *(u32x4*)(p + HALF) = pack8(acc[ai][1][m][0], acc[ai][1][m][1]); }
                else if (pn < 4) { bf16_t* p = U + (size_t)row * 256 + (pn - 2) * HALF + cw;
                    *(u32x4*)p = pack8(acc[ai][0][m][0] * sigm4(acc[ai][1][m][0]), acc[ai][0][m][1] * sigm4(acc[ai][1][m][1])); }
                else if (pn < 6) { bf16_t* p = ZC + (size_t)row * 512 + (pn - 4) * 256 + cw;
                    *(u32x4*)p = pack8(acc[ai][0][m][0], acc[ai][0][m][1]); *(u32x4*)(p + HALF) = pack8(acc[ai][1][m][0], acc[ai][1][m][1]); }
                else { const int b = row >> 13, s = row & 8191, s1 = s >> 6, s2 = s & 63;
#pragma unroll
                    for (int bj = 0; bj < 2; ++bj) { const int cz = (pn - 6) * 256 + bj * HALF + cw, g = cz >> 7, c = cz & 127;
                        bf16_t* p = ZD + ((size_t)(((b * 64 + s2) * 4 + g) * 128 + s1)) * 128 + c;
                        *(u32x4*)p = pack8(acc[ai][bj][m][0], acc[ai][bj][m][1]); } }
            }
    }
};
struct EpiQ {
    static constexpr bool PERM = false, AFTER_DRAIN = false;
    bf16_t* Q; const float* cosT; const float* sinT; float c2;
    __device__ __forceinline__ void operator()(const f32x4 (&acc)[2][2][4][2], const Unit& u, int wr, int wc, int fr, int fq) const {
        const int row0 = u.pm * BM + wr * 64 + fr;
#pragma unroll
        for (int bj = 0; bj < 2; ++bj) { const int g32 = u.pn * 8 + bj * 4 + wc, head = g32 / 3, part = g32 - head * 3;
#pragma unroll
            for (int ai = 0; ai < 2; ++ai)
#pragma unroll
                for (int m = 0; m < 4; ++m) { asm volatile("" ::: "memory"); const int row = row0 + ai * HALF + m * 16, b = row >> 13, s = row & 8191;
                    bf16_t* p = Q + ((size_t)((b * 8 + head) * 8192 + s)) * 96 + part * 32 + 4 * fq;
                    f32x4 x1 = acc[ai][bj][m][0], x2 = acc[ai][bj][m][1];
                    if (part == 2) { const f32x4 c = *(const f32x4*)(cosT + s * 16 + 4 * fq), sn = *(const f32x4*)(sinT + s * 16 + 4 * fq);
                        const f32x4 o1 = x1 * c - x2 * sn, o2 = x1 * sn + x2 * c; x1 = o1; x2 = o2; }
                    *(u32x2*)p = pack4(x1 * c2); *(u32x2*)(p + 16) = pack4(x2 * c2); }
        }
    }
};
struct EpiK {
    static constexpr bool PERM = true, AFTER_DRAIN = false;
    bf16_t* Kn;
    __device__ __forceinline__ void operator()(const f32x4 (&acc)[2][2][4][2], const Unit& u, int wr, int wc, int fr, int fq) const {
        const int row0 = u.pm * BM + wr * 64 + fr;
#pragma unroll
        for (int bj = 0; bj < 2; ++bj) { const int col = u.pn * BM + bj * HALF + wc * 32 + 8 * fq, hd = col >> 6, c = col & 63;
#pragma unroll
            for (int ai = 0; ai < 2; ++ai)
#pragma unroll
                for (int m = 0; m < 4; ++m) { asm volatile("" ::: "memory"); const int row = row0 + ai * HALF + m * 16, b = row >> 13, s = row & 8191;
                    *(u32x4*)(Kn + ((size_t)((b * 8 + hd) * 8192 + s)) * 64 + c) = pack8(acc[ai][bj][m][0], acc[ai][bj][m][1]); }
        }
    }
};
struct EpiVt {
    static constexpr bool PERM = true, AFTER_DRAIN = false;
    bf16_t* Vt;
    __device__ __forceinline__ void operator()(const f32x4 (&acc)[2][2][4][2], const Unit& u, int wr, int wc, int fr, int fq) const {
        const int row0 = u.pm * BM + wr * 64 + fr;
#pragma unroll
        for (int bj = 0; bj < 2; ++bj) { const int t0 = u.pn * BM + bj * HALF + wc * 32 + 8 * fq, b = t0 >> 13, s = t0 & 8191;
#pragma unroll
            for (int ai = 0; ai < 2; ++ai)
#pragma unroll
                for (int m = 0; m < 4; ++m) { asm volatile("" ::: "memory"); const int row = row0 + ai * HALF + m * 16;
                    *(u32x4*)(Vt + ((size_t)(b * 512 + row)) * 8192 + s) = pack8(acc[ai][bj][m][0], acc[ai][bj][m][1]); }
        }
    }
};
struct EpiDftC {
    static constexpr bool PERM = true, AFTER_DRAIN = false;
    bf16_t* Zt;
    __device__ __forceinline__ void operator()(const f32x4 (&acc)[2][2][4][2], const Unit& u, int wr, int wc, int fr, int fq) const {
#pragma unroll
        for (int bj = 0; bj < 2; ++bj) { const int n = u.pn * BM + bj * HALF + wc * 32 + 8 * fq, s1 = n & 127, g = (n >> 7) & 3, s2 = (n >> 9) & 63, b = n >> 15;
#pragma unroll
            for (int ai = 0; ai < 2; ++ai)
#pragma unroll
                for (int m = 0; m < 4; ++m) { asm volatile("" ::: "memory"); const int kc = wr * 64 + m * 16 + fr;
                    *(u32x4*)(Zt + ((size_t)(((b * 4 + g) * 128 + kc) * 64 + s2)) * 256 + ai * 128 + s1) = pack8(acc[ai][bj][m][0], acc[ai][bj][m][1]); }
        }
    }
};
struct EpiFftA {
    static constexpr bool PERM = true, AFTER_DRAIN = false;
    bf16_t* Yp; const f32x2_t* tw;
    __device__ __forceinline__ void operator()(const f32x4 (&acc)[2][2][4][2], const Unit& u, int wr, int wc, int fr, int fq) const {
#pragma unroll
        for (int bj = 0; bj < 2; ++bj) { const int n = u.pn * BM + bj * HALF + wc * 32 + 8 * fq, s2 = n & 63, rest = n >> 6, kc = rest & 127, bg = rest >> 7, b = bg >> 2, g = bg & 3;
#pragma unroll
            for (int m = 0; m < 4; ++m) { asm volatile("" ::: "memory"); int k1 = wr * 64 + m * 16 + fr; asm volatile("" : "+v"(k1));
                bf16_t* p = Yp + ((size_t)(((b * 128 + k1) * 4 + g) * 128 + kc)) * 128 + s2;
#pragma unroll
                for (int hv = 0; hv < 2; ++hv) { f32x4 rr, ii;
#pragma unroll
                    for (int e = 0; e < 4; ++e) { const f32x2_t t0 = tw[k1 * (s2 + 4 * hv + e)]; const float yr = acc[0][bj][m][hv][e], yi = acc[1][bj][m][hv][e];
                        rr[e] = yr * t0.x + yi * t0.y; ii[e] = yi * t0.x - yr * t0.y; }
                    *(u32x2*)(p + 4 * hv) = pack4(rr); *(u32x2*)(p + 64 + 4 * hv) = pack4(ii); asm volatile("" ::: "memory"); }
            }
        }
    }
};
struct EpiFftC {
    static constexpr bool PERM = true, AFTER_DRAIN = false;
    bf16_t* F;
    __device__ __forceinline__ void operator()(const f32x4 (&acc)[2][2][4][2], const Unit& u, int wr, int wc, int fr, int fq) const {
        if (wr != 0) return;
#pragma unroll
        for (int bj = 0; bj < 2; ++bj) { const int n = u.pn * BM + bj * HALF + wc * 32 + 8 * fq, kc = n & 127, g = (n >> 7) & 3, k1 = (n >> 9) & 127, b = n >> 16;
#pragma unroll
            for (int m = 0; m < 4; ++m) { asm volatile("" ::: "memory"); const int k2 = m * 16 + fr;
                *(u32x4*)(F + ((size_t)(b * 8192 + k1 + 128 * k2)) * 512 + g * 128 + kc) = pack8(acc[0][bj][m][0], acc[0][bj][m][1]); }
        }
    }
};
struct EpiMerge {
    static constexpr bool PERM = true, AFTER_DRAIN = false;
    bf16_t* Mg; const bf16_t* G; int br;
    __device__ __forceinline__ void operator()(const f32x4 (&acc)[2][2][4][2], const Unit& u, int wr, int wc, int fr, int fq) const {
        const int row0 = u.pm * BM + wr * 64 + fr, col0 = u.pn * BM + wc * 32 + 8 * fq;
#pragma unroll
        for (int ai = 0; ai < 2; ++ai)
#pragma unroll
            for (int m = 0; m < 4; ++m) { asm volatile("" ::: "memory"); const int row = row0 + ai * HALF + m * 16;
#pragma unroll
                for (int bj = 0; bj < 2; ++bj) { const int col = col0 + bj * HALF;
                    const u32x4 gw = *(const u32x4*)(G + (size_t)row * 4096 + br * 1024 + col);
                    f32x4 v0 = acc[ai][bj][m][0], v1 = acc[ai][bj][m][1];
                    if ((DBG_MASK >> br) & 1) { v0 = v0 * 0.f; v1 = v1 * 0.f; }
                    v0[0] *= bflo(gw.x); v0[1] *= bfhi(gw.x); v0[2] *= bflo(gw.y); v0[3] *= bfhi(gw.y); v1[0] *= bflo(gw.z); v1[1] *= bfhi(gw.z); v1[2] *= bflo(gw.w); v1[3] *= bfhi(gw.w);
                    bf16_t* p = Mg + (size_t)row * 1024 + col;
                    if (br > 0) { const u32x4 o = *(const u32x4*)p;
                        v0[0] += bflo(o.x); v0[1] += bfhi(o.x); v0[2] += bflo(o.y); v0[3] += bfhi(o.y); v1[0] += bflo(o.z); v1[1] += bfhi(o.z); v1[2] += bflo(o.w); v1[3] += bfhi(o.w); }
                    *(u32x4*)p = pack8(v0, v1); }
            }
    }
};

template <class Epi, class Sched, bool ALIGN_EPI = false, bool SP2 = false>
__device__ __forceinline__ void gemm_phase(PG8_LAS unsigned char* lds, const Gemm g, const Sched& S, const Epi& E) {
    int tid_ = threadIdx.x; asm volatile("" : "+v"(tid_)); const int tid = tid_, wid = __builtin_amdgcn_readfirstlane(tid >> 6), lane = tid & 63, wr = wid >> 2, wc = wid & 3, fr = lane & 15, fq = lane >> 4;
    const int K = g.K, nt = K / BK;
    unsigned voffA[2], voffB[2];
#pragma unroll
    for (int i = 0; i < 2; ++i) { int R, C; stage_rc(tid * 16 + i * 8192, R, C); const int Rb = Epi::PERM ? ((R & ~31) + perm32(R & 31)) : R;
        voffA[i] = (unsigned)(R * K + C) * 2u; voffB[i] = (unsigned)(Rb * K + C) * 2u; }
    const size_t kstep = (size_t)(BK * 2);
    const size_t hstep = (size_t)HALF * K * 2;
    const size_t tstep = 2 * hstep;
    const unsigned ldsw = (unsigned)wid * 1024u;
    const int aoff = lds_byte(wr * 64 + fr, fq * 8), boff = lds_byte(wc * 32 + fr, fq * 8);
#define PG8_SA(b, h) (((b) * 2 + (h)) * HTB)
#define PG8_SB(b, h) ((4 + (b) * 2 + (h)) * HTB)
#define PG8_STAGE(bufoff, gbase, voff) do { _Pragma("unroll") for (int _i = 0; _i < 2; ++_i) \
        __builtin_amdgcn_global_load_lds((const unsigned*)((const char*)(gbase) + (voff)[_i]), (PG8_LAS unsigned*)(lds + (bufoff) + ldsw + _i * 8192), 16, 0, 0); } while (0)
#define PG8_LDA(dst, b, h) do { _Pragma("unroll") for (int m = 0; m < 4; ++m) _Pragma("unroll") for (int k = 0; k < 2; ++k) dst[m][k] = *(const PG8_LAS bf16x8*)(lds + PG8_SA(b, h) + aoff + m * 2048 + k * 1024); } while (0)
#define PG8_LDB(dst, b, h) do { _Pragma("unroll") for (int n = 0; n < 2; ++n) _Pragma("unroll") for (int k = 0; k < 2; ++k) dst[n][k] = *(const PG8_LAS bf16x8*)(lds + PG8_SB(b, h) + boff + n * 2048 + k * 1024); } while (0)
#define PG8_MMA(ai, bj, At, Bt) do { __builtin_amdgcn_s_setprio(1); _Pragma("unroll") for (int m = 0; m < 4; ++m) _Pragma("unroll") for (int n = 0; n < 2; ++n) _Pragma("unroll") for (int k = 0; k < 2; ++k) \
        acc[ai][bj][m][n] = __builtin_amdgcn_mfma_f32_16x16x32_bf16(Bt[n][k], At[m][k], acc[ai][bj][m][n], 0, 0, 0); __builtin_amdgcn_s_setprio(0); } while (0)
#define PG8_WAIT_V(n) asm volatile("s_waitcnt vmcnt(" #n ")" ::: "memory")
#define PG8_WAIT_L(n) asm volatile("s_waitcnt lgkmcnt(" #n ")" ::: "memory")
#define PG8_BAR __builtin_amdgcn_s_barrier()
#define PG8_SCHED __builtin_amdgcn_sched_barrier(0)
    Unit cur, nxt; int ui = 0;
    if (!S.next(0, cur)) return;
    f32x4 acc[2][2][4][2];
#pragma unroll
    for (int a = 0; a < 2; ++a)
#pragma unroll
        for (int b = 0; b < 2; ++b)
#pragma unroll
            for (int m = 0; m < 4; ++m)
#pragma unroll
                for (int n = 0; n < 2; ++n) acc[a][b][m][n] = (f32x4){0.f, 0.f, 0.f, 0.f};
    bf16x8 At[4][2], B0[2][2], B1[2][2];
    const char* cA = (const char*)g.A + (size_t)cur.pm * tstep; const char* cB = (const char*)g.Bt + (size_t)cur.pn * tstep;
    S.a_ready(cur);
    if constexpr (SP2) {
        PG8_STAGE(PG8_SB(0, 0), cB, voffB); PG8_STAGE(PG8_SB(0, 1), cB + hstep, voffB); PG8_STAGE(PG8_SA(0, 0), cA, voffA); PG8_STAGE(PG8_SA(0, 1), cA + hstep, voffA);
        if (wr == 1) PG8_BAR;
        PG8_WAIT_V(2); PG8_BAR;
        PG8_STAGE(PG8_SB(1, 0), cB + kstep, voffB); PG8_STAGE(PG8_SA(1, 0), cA + kstep, voffA); PG8_STAGE(PG8_SB(1, 1), cB + hstep + kstep, voffB);
        PG8_WAIT_V(6); PG8_BAR;
    } else {
        PG8_STAGE(PG8_SB(0, 0), cB, voffB); PG8_STAGE(PG8_SA(0, 0), cA, voffA); PG8_STAGE(PG8_SB(0, 1), cB + hstep, voffB); PG8_STAGE(PG8_SA(0, 1), cA + hstep, voffA);
        if (wr == 1) PG8_BAR;
        PG8_WAIT_V(4); PG8_BAR;
        PG8_STAGE(PG8_SB(1, 0), cB + kstep, voffB); PG8_STAGE(PG8_SA(1, 0), cA + kstep, voffA); PG8_STAGE(PG8_SB(1, 1), cB + hstep + kstep, voffB);
        PG8_WAIT_V(6); PG8_BAR;
    }
    for (;;) {
        const bool has_next = S.next(ui + 1, nxt);
        const char* nA = has_next ? (const char*)g.A + (size_t)nxt.pm * tstep : cA; const char* nB = has_next ? (const char*)g.Bt + (size_t)nxt.pn * tstep : cB;
        for (int t = 0; t < nt; t += 2) {
            const bool last = (t == nt - 2);
            const char* a1 = cA + (size_t)(t + 1) * kstep;
            const char* a2 = last ? nA : cA + (size_t)(t + 2) * kstep; const char* b2 = last ? nB : cB + (size_t)(t + 2) * kstep;
            const char* a3 = a2 + kstep; const char* b3 = b2 + kstep;
            if (last && has_next) S.a_ready(nxt);
            if constexpr (SP2) {
            PG8_LDB(B0, 0, 0); PG8_LDB(B1, 0, 1); PG8_SCHED; PG8_LDA(At, 0, 0); PG8_STAGE(PG8_SA(1, 1), a1 + hstep, voffA);
            PG8_WAIT_V(8); PG8_WAIT_L(0); PG8_BAR; PG8_MMA(0, 0, At, B0); PG8_MMA(0, 1, At, B1); PG8_BAR; PG8_SCHED;
            PG8_LDA(At, 0, 1); PG8_STAGE(PG8_SB(0, 0), b2, voffB); PG8_STAGE(PG8_SB(0, 1), b2 + hstep, voffB); PG8_STAGE(PG8_SA(0, 0), a2, voffA);
            PG8_WAIT_V(8); PG8_WAIT_L(0); PG8_BAR; PG8_MMA(1, 0, At, B0); PG8_MMA(1, 1, At, B1); PG8_BAR; PG8_SCHED;
            PG8_LDB(B0, 1, 0); PG8_LDB(B1, 1, 1); PG8_SCHED; PG8_LDA(At, 1, 0); PG8_STAGE(PG8_SA(0, 1), a2 + hstep, voffA);
            PG8_WAIT_V(8); PG8_WAIT_L(0); PG8_BAR; PG8_MMA(0, 0, At, B0); PG8_MMA(0, 1, At, B1); PG8_BAR; PG8_SCHED;
            PG8_LDA(At, 1, 1); PG8_STAGE(PG8_SB(1, 0), b3, voffB); PG8_STAGE(PG8_SB(1, 1), b3 + hstep, voffB); PG8_STAGE(PG8_SA(1, 0), a3, voffA);
            PG8_WAIT_V(8); PG8_WAIT_L(0); PG8_BAR; PG8_MMA(1, 0, At, B0); PG8_MMA(1, 1, At, B1); PG8_BAR; PG8_SCHED;
            } else {
            PG8_LDB(B0, 0, 0); PG8_SCHED; PG8_LDA(At, 0, 0); PG8_STAGE(PG8_SA(1, 1), a1 + hstep, voffA);
            PG8_WAIT_L(8); PG8_BAR; PG8_WAIT_L(0); PG8_MMA(0, 0, At, B0); PG8_BAR; PG8_SCHED;
            PG8_LDB(B1, 0, 1); PG8_STAGE(PG8_SB(0, 0), b2, voffB);
            PG8_BAR; PG8_WAIT_L(0); PG8_MMA(0, 1, At, B1); PG8_BAR;
            PG8_LDA(At, 0, 1); PG8_STAGE(PG8_SA(0, 0), a2, voffA);
            PG8_BAR; PG8_WAIT_L(0); PG8_MMA(1, 0, At, B0); PG8_BAR; PG8_SCHED;
            PG8_STAGE(PG8_SB(0, 1), b2 + hstep, voffB);
            PG8_WAIT_V(6); PG8_BAR; PG8_MMA(1, 1, At, B1); PG8_BAR;
            PG8_LDB(B0, 1, 0); PG8_SCHED; PG8_LDA(At, 1, 0); PG8_STAGE(PG8_SA(0, 1), a2 + hstep, voffA);
            PG8_WAIT_L(8); PG8_BAR; PG8_WAIT_L(0); PG8_MMA(0, 0, At, B0); PG8_BAR; PG8_SCHED;
            PG8_LDB(B1, 1, 1); PG8_STAGE(PG8_SB(1, 0), b3, voffB);
            PG8_BAR; PG8_WAIT_L(0); PG8_MMA(0, 1, At, B1); PG8_BAR;
            PG8_LDA(At, 1, 1); PG8_STAGE(PG8_SA(1, 0), a3, voffA);
            PG8_BAR; PG8_WAIT_L(0); PG8_MMA(1, 0, At, B0); PG8_BAR; PG8_SCHED;
            PG8_STAGE(PG8_SB(1, 1), b3 + hstep, voffB);
            PG8_WAIT_V(6); PG8_BAR; PG8_MMA(1, 1, At, B1); PG8_BAR;
            }
        }
        if constexpr (ALIGN_EPI) { if (wr == 0) PG8_BAR; }
        if constexpr (!Epi::AFTER_DRAIN) { E(acc, cur, wr, wc, fr, fq); S.done(cur); }
        if (!has_next) break;
#pragma unroll
        for (int a = 0; a < 2; ++a)
#pragma unroll
            for (int b = 0; b < 2; ++b)
#pragma unroll
                for (int m = 0; m < 4; ++m)
#pragma unroll
                    for (int n = 0; n < 2; ++n) acc[a][b][m][n] = (f32x4){0.f, 0.f, 0.f, 0.f};
        cur = nxt; cA = nA; cB = nB; ++ui;
        if constexpr (ALIGN_EPI) { if (wr == 1) PG8_BAR; }
    }
    PG8_WAIT_V(0);
    if constexpr (!ALIGN_EPI) { if (wr == 0) PG8_BAR; }
    PG8_BAR;
    if constexpr (Epi::AFTER_DRAIN) { E.fused(acc, cur, wr, wc, fr, fq, lds, wid, lane); S.done(cur); }
#undef PG8_SA
#undef PG8_SB
#undef PG8_STAGE
#undef PG8_LDA
#undef PG8_LDB
#undef PG8_MMA
#undef PG8_WAIT_V
#undef PG8_WAIT_L
#undef PG8_BAR
#undef PG8_SCHED
}
}

#define DI __device__ __forceinline__
#define LAS __attribute__((address_space(3)))
typedef unsigned short bf16;
typedef unsigned v4u __attribute__((ext_vector_type(4)));
typedef unsigned v2u __attribute__((ext_vector_type(2)));
typedef float f32x4 __attribute__((ext_vector_type(4)));
typedef float f32x16 __attribute__((ext_vector_type(16)));
typedef short bf16x8 __attribute__((ext_vector_type(8)));
typedef short s16x4 __attribute__((ext_vector_type(4)));
using pg8::pk2; using pg8::bflo; using pg8::bfhi; using pg8::sigm;

constexpr int NWAVES = 8, NTHR = 512;
constexpr int DM = 1024, BATCH = 4, SEQ = 8192, T = BATCH * SEQ, DEPTH = 2, DFF = 2816;
constexpr int QL = 352, QLP = 384, KVL = 128, WIN = 6144, NMOD = 9;
constexpr float EPS = 1e-6f;
constexpr float C2 = 0.10206207261596577f * 1.4426950408889634f;
constexpr int LDS_BYTES = 131072 + 1024;

constexpr size_t MiB = 1u << 20;
constexpr size_t WS_MOD = 0;
constexpr size_t WS_COS = 512 * 1024, WS_SIN = 1 * MiB;
constexpr size_t WS_TW = 1536 * 1024;
constexpr size_t WS_WDFTC = 1792 * 1024;
constexpr size_t WS_WFFTA = 2 * MiB;
constexpr size_t WS_W64 = 2 * MiB + 256 * 1024;
constexpr size_t WS_W = 4 * MiB;
constexpr size_t W_FFN_IN = 0, W_FFN_OUT = 11 * MiB, W_FFN_STRIDE = 16 * MiB + 512 * 1024;
constexpr size_t W_MIXIN = 33 * MiB;
constexpr size_t W_UQ = 45 * MiB;
constexpr size_t W_UKV = 45 * MiB + 640 * 1024;
constexpr size_t W_A = 46 * MiB, W_B = 47 * MiB, W_C = 47 * MiB + 512 * 1024, W_D = 48 * MiB + 512 * 1024, W_OUT = 49 * MiB + 512 * 1024;
constexpr size_t WS_H = 56 * MiB;
constexpr size_t WS_O = 120 * MiB, WS_YB = 152 * MiB, WS_DP = 168 * MiB, WS_F = 200 * MiB;
constexpr size_t WS_TMP = 232 * MiB;
constexpr size_t WS_ACT = WS_TMP, WS_Y = 408 * MiB;
constexpr size_t WS_ZA = 232 * MiB, WS_U = 264 * MiB, WS_ZC = 280 * MiB, WS_ZD = 312 * MiB, WS_CQN = 344 * MiB, WS_CKVN = 368 * MiB, WS_KR = 376 * MiB;
constexpr size_t WS_Q = 380 * MiB, WS_KN = 428 * MiB, WS_VT = 460 * MiB;
constexpr size_t WS_ZT = 232 * MiB, WS_YP = 296 * MiB, WS_GATES = 232 * MiB;
constexpr size_t WS_END = 512 * MiB;

struct Args { const float* in[25]; float* out; unsigned char* ws; };

struct Ctx { int tid, lane, wave, G, bid; LAS unsigned char* lds; };

DI float wave_sum(float v) {
#pragma unroll
    for (int o = 1; o < 64; o <<= 1) v += __shfl_xor(v, o);
    return v;
}
DI void sincos_turns(double turns, float& sn, float& cs) {
    const double r = turns - __builtin_rint(turns);
    const double x = r * 6.283185307179586476925287, x2 = x * x;
    double ts = x, tc = 1.0, s = x, c = 1.0;
#pragma unroll 1
    for (int k = 1; k <= 14; ++k) { tc = -tc * x2 / (double)((2 * k - 1) * (2 * k)); c += tc; ts = -ts * x2 / (double)((2 * k) * (2 * k + 1)); s += ts; }
    sn = (float)s; cs = (float)c;
}

DI void transpose_item(const float* W, int Kreal, int N, bf16* WT, int Kpad, int mode, LAS float* scr, int item, int lane) {
    const int nblk = N / 32, kb = item / nblk, nb = item % nblk, k0 = 64 * kb, n0 = 32 * nb;
#pragma unroll 8
    for (int i = 0; i < 32; ++i) { const int kk = 2 * i + (lane >> 5); scr[kk * 33 + (lane & 31)] = (k0 + kk < Kreal) ? W[(size_t)(k0 + kk) * N + n0 + (lane & 31)] : 0.f; }
    asm volatile("s_waitcnt lgkmcnt(0)" ::: "memory");
    int r0;
    if (mode == 1) { const int half = N / 2; const int j = n0 >= half ? n0 - half : n0; r0 = (j >> 7) * 256 + (n0 >= half ? 128 : 0) + (j & 127); }
    else if (mode == 2) { if (n0 >= 512 && n0 < 1024) { const int j = (n0 - 512) & 255, gt = (n0 - 512) >> 8; r0 = 512 + (j >> 7) * 256 + gt * 128 + (j & 127); } else r0 = n0; }
    else if (mode == 3) { const int hd = n0 >> 7, c = n0 & 127; r0 = (c >= 64 ? 512 : 0) + hd * 64 + (c & 63); }
    else r0 = n0;
    const int c = lane & 7;
#pragma unroll
    for (int j = 0; j < 4; ++j) { const int n = (lane >> 3) + 8 * j; const LAS float* s = scr + (8 * c) * 33 + n;
        v4u o; o.x = pk2(s[0 * 33], s[1 * 33]); o.y = pk2(s[2 * 33], s[3 * 33]); o.z = pk2(s[4 * 33], s[5 * 33]); o.w = pk2(s[6 * 33], s[7 * 33]);
        *(v4u*)(WT + (size_t)(r0 + n) * Kpad + k0 + 8 * c) = o; }
    asm volatile("s_waitcnt lgkmcnt(0)" ::: "memory");
}

DI void convert_weights(const Ctx& F0, const Args& a, int l) {
    Ctx F = F0; asm volatile("" : "+v"(F.tid), "+v"(F.lane));
    LAS float* scr = (LAS float*)(F.lds + F.wave * 16384);
    bf16* Wb = (bf16*)(a.ws + WS_W);
    const int gw = F.bid * NWAVES + F.wave, NGW = F.G * NWAVES;
    constexpr int I_FI = 16 * 176, I_FO = 44 * 32, I_MI = 16 * 192, I_UQ = 6 * 24, I_UKV = 2 * 32, I_A = 8 * 32, I_B = 4 * 32, I_D = 8 * 32, I_O = 16 * 32;
    constexpr int NITEMS = 2 * I_FI + 2 * I_FO + I_MI + I_UQ + I_UKV + I_A + I_B + I_D + I_O;
    for (int it = gw; it < NITEMS; it += NGW) {
        int r = it;
        if (r < I_FI) { transpose_item(a.in[5] + (size_t)l * DM * 2 * DFF, DM, 2 * DFF, Wb + (W_FFN_IN) / 2, DM, 1, scr, r, F.lane); continue; } r -= I_FI;
        if (r < I_FI) { transpose_item(a.in[7] + (size_t)l * DM * 2 * DFF, DM, 2 * DFF, Wb + (W_FFN_STRIDE + W_FFN_IN) / 2, DM, 1, scr, r, F.lane); continue; } r -= I_FI;
        if (r < I_FO) { transpose_item(a.in[6] + (size_t)l * DFF * DM, DFF, DM, Wb + (W_FFN_OUT) / 2, DFF, 0, scr, r, F.lane); continue; } r -= I_FO;
        if (r < I_FO) { transpose_item(a.in[8] + (size_t)l * DFF * DM, DFF, DM, Wb + (W_FFN_STRIDE + W_FFN_OUT) / 2, DFF, 0, scr, r, F.lane); continue; } r -= I_FO;
        if (r < I_MI) { transpose_item(a.in[9] + (size_t)l * DM * WIN, DM, WIN, Wb + W_MIXIN / 2, DM, 2, scr, r, F.lane); continue; } r -= I_MI;
        if (r < I_UQ) { transpose_item(a.in[11] + (size_t)l * QL * 768, QL, 768, Wb + W_UQ / 2, QLP, 0, scr, r, F.lane); continue; } r -= I_UQ;
        if (r < I_UKV) { transpose_item(a.in[13] + (size_t)l * KVL * 1024, KVL, 1024, Wb + W_UKV / 2, KVL, 3, scr, r, F.lane); continue; } r -= I_UKV;
        if (r < I_A) { transpose_item(a.in[14] + (size_t)l * 512 * DM, 512, DM, Wb + W_A / 2, 512, 0, scr, r, F.lane); continue; } r -= I_A;
        if (r < I_B) { transpose_item(a.in[19] + (size_t)l * 256 * DM, 256, DM, Wb + W_B / 2, 256, 0, scr, r, F.lane); continue; } r -= I_B;
        if (r < I_D) { transpose_item(a.in[23] + (size_t)l * 512 * DM, 512, DM, Wb + W_D / 2, 512, 0, scr, r, F.lane); continue; } r -= I_D;
        transpose_item(a.in[24] + (size_t)l * DM * DM, DM, DM, Wb + W_OUT / 2, DM, 0, scr, r, F.lane);
    }
    const float* pw = a.in[20] + (size_t)l * 4 * 128 * 128; const float* ps = a.in[21] + (size_t)l * 512; const float* wc = a.in[22] + (size_t)l * 512 * DM;
    bf16* WcT = Wb + W_C / 2;
    for (int o = F.bid * NTHR + F.tid; o < 512 * DM; o += F.G * NTHR) {
        const int n = o & 1023, k = o >> 10, g = k >> 7;
        const float* pr = pw + (size_t)k * 128; const float* sc = ps + g * 128; const float* wr = wc + (size_t)(g * 128) * DM + n;
        float acc = 0.f;
#pragma unroll 4
        for (int d = 0; d < 128; ++d) acc += pr[d] * sc[d] * wr[(size_t)d * DM];
        WcT[(size_t)n * 512 + k] = (bf16)(pk2(acc, 0.f) & 0xffffu);
    }
}

DI void build_tables(const Ctx& F, const Args& a) {
    const int gt = F.bid * NTHR + F.tid, NT_ = F.G * NTHR;
    float* cosT = (float*)(a.ws + WS_COS); float* sinT = (float*)(a.ws + WS_SIN);
    for (int o = gt; o < SEQ * 16; o += NT_) { const int s = o >> 4, i = o & 15;
        const float inv = __builtin_amdgcn_exp2f(-(float)i * (13.287712379549449f / 16.0f));
        const float ang = (float)s * inv; float sn, cs; sincos_turns((double)ang * 0.15915494309189533577, sn, cs); cosT[o] = cs; sinT[o] = sn; }
    float* tw = (float*)(a.ws + WS_TW);
    for (int o = gt; o < 8192; o += NT_) { float sn, cs; sincos_turns((double)o / 8192.0, sn, cs); tw[2 * o] = cs; tw[2 * o + 1] = sn; }
    bf16* wdc = (bf16*)(a.ws + WS_WDFTC);
    for (int o = gt; o < 256 * 128; o += NT_) { const int m = o >> 7, c = o & 127, ri = m >> 7, kc = m & 127; float sn, cs; sincos_turns((double)((kc * c) & 127) / 128.0, sn, cs);
        const float v = (ri == 0 ? cs : -sn) * 0.08838834764831845f; wdc[o] = (bf16)(pk2(v, 0.f) & 0xffffu); }
    bf16* wfa = (bf16*)(a.ws + WS_WFFTA);
    for (int o = gt; o < 256 * 256; o += NT_) { const int m = o >> 8, k = o & 255, rp = m >> 7, k1 = m & 127, ri = k >> 7, s1 = k & 127; float sn, cs; sincos_turns((double)((k1 * s1) & 127) / 128.0, sn, cs);
        const float v = (rp == ri ? cs : (rp == 0 ? sn : -sn)) * 0.08838834764831845f; wfa[o] = (bf16)(pk2(v, 0.f) & 0xffffu); }
    bf16* w64 = (bf16*)(a.ws + WS_W64);
    for (int o = gt; o < 256 * 128; o += NT_) { const int m = o >> 7, k = o & 127, ri = k >> 6, s2 = k & 63; float sn, cs; sincos_turns((double)((m * s2) & 63) / 64.0, sn, cs);
        const float v = m < 64 ? (ri == 0 ? cs : sn) * 0.125f : 0.f; w64[o] = (bf16)(pk2(v, 0.f) & 0xffffu); }
}

DI void compute_mod(const Ctx& F, const Args& a) {
    LAS float* sc = (LAS float*)F.lds;
    LAS float* part = (LAS float*)(F.lds + 16384);
    const float* c = a.in[1];
    for (int i = F.tid; i < 4 * DM; i += NTHR) { const float v = c[i]; sc[i] = v * sigm(v); }
    __syncthreads();
    float* mod = (float*)(a.ws + WS_MOD);
    for (int it = F.bid; it < DEPTH * 144; it += F.G) {
        const int l = it / 144, j0 = (it % 144) * 64, j = j0 + F.lane;
        const float* w = a.in[2] + (size_t)l * DM * (NMOD * DM) + j;
        float a0 = 0.f, a1 = 0.f, a2 = 0.f, a3 = 0.f;
        const int kb = F.wave * 128;
#pragma unroll 4
        for (int k = 0; k < 128; ++k) { const float wv = w[(size_t)(kb + k) * (NMOD * DM)]; a0 += sc[kb + k] * wv; a1 += sc[1024 + kb + k] * wv; a2 += sc[2048 + kb + k] * wv; a3 += sc[3072 + kb + k] * wv; }
        part[(F.wave * 4 + 0) * 64 + F.lane] = a0; part[(F.wave * 4 + 1) * 64 + F.lane] = a1; part[(F.wave * 4 + 2) * 64 + F.lane] = a2; part[(F.wave * 4 + 3) * 64 + F.lane] = a3;
        __syncthreads();
        if (F.wave < 4) { float s = a.in[3][(size_t)l * NMOD * DM + j];
#pragma unroll
            for (int w8 = 0; w8 < 8; ++w8) s += part[(w8 * 4 + F.wave) * 64 + F.lane];
            mod[((size_t)l * 4 + F.wave) * (NMOD * DM) + j] = s; }
        __syncthreads();
    }
}

DI void rowwise(const Ctx& F0, const float* xin, const bf16* y, float ymul, const float* gate, const float* gy, float* xout,
                const float* gn, const float* shift, const float* scale, bf16* H, bool has_y, bool has_next) {
    Ctx F = F0; asm volatile("" : "+v"(F.tid), "+v"(F.lane));
    const int gw = F.bid * NWAVES + F.wave, NGW = F.G * NWAVES;
    for (int r = gw; r < T; r += NGW) {
        const int b = r >> 13; const size_t ro = (size_t)r * DM;
        f32x4 x[4];
#pragma unroll
        for (int j = 0; j < 4; ++j) x[j] = *(const f32x4*)(xin + ro + 4 * F.lane + 256 * j);
        if (has_y) {
            f32x4 yv[4]; float ss = 0.f;
#pragma unroll
            for (int j = 0; j < 4; ++j) { const v2u w = *(const v2u*)(y + ro + 4 * F.lane + 256 * j); yv[j] = (f32x4){bflo(w.x), bfhi(w.x), bflo(w.y), bfhi(w.y)};
                ss += (yv[j][0] * yv[j][0] + yv[j][1] * yv[j][1]) + (yv[j][2] * yv[j][2] + yv[j][3] * yv[j][3]); }
            const float ry = __builtin_amdgcn_rsqf(wave_sum(ss) * (1.0f / DM) + EPS) * ymul;
#pragma unroll
            for (int j = 0; j < 4; ++j) { const int c = 4 * F.lane + 256 * j; const f32x4 gt = *(const f32x4*)(gate + (size_t)b * (NMOD * DM) + c), gg = *(const f32x4*)(gy + c);
                x[j] += gt * (yv[j] * ry * gg); }
        }
#pragma unroll
        for (int j = 0; j < 4; ++j) *(f32x4*)(xout + ro + 4 * F.lane + 256 * j) = x[j];
        if (has_next) {
            float ss = 0.f;
#pragma unroll
            for (int j = 0; j < 4; ++j) ss += (x[j][0] * x[j][0] + x[j][1] * x[j][1]) + (x[j][2] * x[j][2] + x[j][3] * x[j][3]);
            const float rx = __builtin_amdgcn_rsqf(wave_sum(ss) * (1.0f / DM) + EPS);
#pragma unroll
            for (int j = 0; j < 4; ++j) { const int c = 4 * F.lane + 256 * j;
                const f32x4 gg = *(const f32x4*)(gn + c), sh = *(const f32x4*)(shift + (size_t)b * (NMOD * DM) + c), sc = *(const f32x4*)(scale + (size_t)b * (NMOD * DM) + c);
                const f32x4 h = (x[j] * rx * gg) * (sc + 1.0f) + sh;
                v2u w; w.x = pk2(h[0], h[1]); w.y = pk2(h[2], h[3]); *(v2u*)(H + ro + c) = w; }
        }
    }
}

DI void mixer_pre(const Ctx& F0, const Args& a, int l) {
    Ctx F = F0; asm volatile("" : "+v"(F.tid), "+v"(F.lane));
    const bf16* ZA = (const bf16*)(a.ws + WS_ZA); const bf16* U = (const bf16*)(a.ws + WS_U); const bf16* ZC = (const bf16*)(a.ws + WS_ZC);
    bf16* cqn = (bf16*)(a.ws + WS_CQN); bf16* ckvn = (bf16*)(a.ws + WS_CKVN); bf16* kr = (bf16*)(a.ws + WS_KR);
    bf16* yb = (bf16*)(a.ws + WS_YB); bf16* dp = (bf16*)(a.ws + WS_DP);
    const float* cosT = (const float*)(a.ws + WS_COS); const float* sinT = (const float*)(a.ws + WS_SIN);
    const float* qg = a.in[10] + (size_t)l * QL; const float* kvg = a.in[12] + (size_t)l * KVL;
    const int gw = F.bid * NWAVES + F.wave, NGW = F.G * NWAVES; const int lane = F.lane;
    for (int r = gw; r < T; r += NGW) {
        const int s = r & 8191;
        const v4u w = *(const v4u*)(ZA + (size_t)r * 512 + lane * 8);
        float f[8] = {bflo(w.x), bfhi(w.x), bflo(w.y), bfhi(w.y), bflo(w.z), bfhi(w.z), bflo(w.w), bfhi(w.w)};
        float ss = 0.f;
#pragma unroll
        for (int j = 0; j < 8; ++j) ss += f[j] * f[j];
        const float ssq = wave_sum(lane < 44 ? ss : 0.f), sskv = wave_sum((lane >= 44 && lane < 60) ? ss : 0.f);
        const float rq = __builtin_amdgcn_rsqf(ssq * (1.0f / QL) + EPS), rkv = __builtin_amdgcn_rsqf(sskv * (1.0f / KVL) + EPS);
        float oth[8];
#pragma unroll
        for (int j = 0; j < 8; ++j) oth[j] = __shfl_xor(f[j], 2);
        if (lane < 44) { const f32x4 g0 = *(const f32x4*)(qg + lane * 8), g1 = *(const f32x4*)(qg + lane * 8 + 4);
            v4u o; o.x = pk2(f[0] * rq * g0[0], f[1] * rq * g0[1]); o.y = pk2(f[2] * rq * g0[2], f[3] * rq * g0[3]); o.z = pk2(f[4] * rq * g1[0], f[5] * rq * g1[1]); o.w = pk2(f[6] * rq * g1[2], f[7] * rq * g1[3]);
            *(v4u*)(cqn + (size_t)r * QLP + lane * 8) = o;
        } else if (lane < 60) { const int c0 = (lane - 44) * 8; const f32x4 g0 = *(const f32x4*)(kvg + c0), g1 = *(const f32x4*)(kvg + c0 + 4);
            v4u o; o.x = pk2(f[0] * rkv * g0[0], f[1] * rkv * g0[1]); o.y = pk2(f[2] * rkv * g0[2], f[3] * rkv * g0[3]); o.z = pk2(f[4] * rkv * g1[0], f[5] * rkv * g1[1]); o.w = pk2(f[6] * rkv * g1[2], f[7] * rkv * g1[3]);
            *(v4u*)(ckvn + (size_t)r * KVL + c0) = o;
            if (lane < 48) { const v4u z = {0u, 0u, 0u, 0u}; *(v4u*)(cqn + (size_t)r * QLP + QL + (lane - 44) * 8) = z; }
        } else { const int hi2 = (lane >= 62), i0 = ((lane - 60) & 1) * 8;
            const f32x4 c0 = *(const f32x4*)(cosT + s * 16 + i0), c1 = *(const f32x4*)(cosT + s * 16 + i0 + 4), s0 = *(const f32x4*)(sinT + s * 16 + i0), s1 = *(const f32x4*)(sinT + s * 16 + i0 + 4);
            float o8[8];
#pragma unroll
            for (int j = 0; j < 8; ++j) { const float cc = j < 4 ? c0[j & 3] : c1[j & 3], sn = j < 4 ? s0[j & 3] : s1[j & 3];
                o8[j] = hi2 ? (oth[j] * sn + f[j] * cc) : (f[j] * cc - oth[j] * sn); }
            v4u o; o.x = pk2(o8[0], o8[1]); o.y = pk2(o8[2], o8[3]); o.z = pk2(o8[4], o8[5]); o.w = pk2(o8[6], o8[7]);
            *(v4u*)(kr + (size_t)r * 32 + hi2 * 16 + i0) = o; }
        { const int g = lane >> 4, wlen = 2 << g, lo = wlen >> 1; float sum[8] = {0.f, 0.f, 0.f, 0.f, 0.f, 0.f, 0.f, 0.f}; int cnt = 0;
          const bf16* zb = ZC + (size_t)(r - s) * 512 + lane * 8;
#pragma unroll 4
          for (int k = 0; k < 16; ++k) { const int sr = s - lo + k;
              if (k < wlen && sr >= 0 && sr < SEQ) { const v4u v = *(const v4u*)(zb + (size_t)sr * 512); ++cnt;
                  sum[0] += bflo(v.x); sum[1] += bfhi(v.x); sum[2] += bflo(v.y); sum[3] += bfhi(v.y); sum[4] += bflo(v.z); sum[5] += bfhi(v.z); sum[6] += bflo(v.w); sum[7] += bfhi(v.w); } }
          const v4u v = *(const v4u*)(zb + (size_t)s * 512); const float ic = 1.0f / (float)cnt;
          v4u o; o.x = pk2(sum[0] * ic - bflo(v.x), sum[1] * ic - bfhi(v.x)); o.y = pk2(sum[2] * ic - bflo(v.y), sum[3] * ic - bfhi(v.y));
          o.z = pk2(sum[4] * ic - bflo(v.z), sum[5] * ic - bfhi(v.z)); o.w = pk2(sum[6] * ic - bflo(v.w), sum[7] * ic - bfhi(v.w));
          *(v4u*)(dp + (size_t)r * 512 + lane * 8) = o; }
    }
    LAS float* lu = (LAS float*)F.lds;
    LAS float* ly = (LAS float*)(F.lds + 62 * 256 * 4);
    const float* cw = a.in[15] + (size_t)l * 31 * 256; const float* cb = a.in[16] + (size_t)l * 256;
    const float* lg = a.in[17] + (size_t)l * 256; const float* lb = a.in[18] + (size_t)l * 256;
    const int ch = F.tid & 255, part = F.tid >> 8;
    float wreg[31];
#pragma unroll
    for (int j = 0; j < 31; ++j) wreg[j] = cw[j * 256 + ch];
    const float bias = cb[ch];
    for (int tile = F.bid; tile < T / 32; tile += F.G) {
        const int t0 = tile * 32, s0 = t0 & 8191, tb = t0 - s0;
        for (int c = F.tid; c < 62 * 32; c += NTHR) { const int row = c >> 5, cc = c & 31, sr = s0 - 15 + row;
            v4u v = {0u, 0u, 0u, 0u}; if (sr >= 0 && sr < SEQ) v = *(const v4u*)(U + (size_t)(tb + sr) * 256 + cc * 8);
            LAS float* d = lu + row * 256 + cc * 8;
            *(LAS f32x4*)d = (f32x4){bflo(v.x), bfhi(v.x), bflo(v.y), bfhi(v.y)}; *(LAS f32x4*)(d + 4) = (f32x4){bflo(v.z), bfhi(v.z), bflo(v.w), bfhi(v.w)}; }
        __syncthreads();
#pragma unroll 2
        for (int tk = 0; tk < 16; ++tk) { const int tok = part * 16 + tk; float acc = bias;
#pragma unroll
            for (int j = 0; j < 31; ++j) acc += wreg[j] * lu[(tok + j) * 256 + ch];
            ly[tok * 256 + ch] = acc; }
        __syncthreads();
#pragma unroll
        for (int q = 0; q < 4; ++q) { const int tok = F.wave * 4 + q; const f32x4 v = *(const LAS f32x4*)(ly + tok * 256 + lane * 4);
            const float mean = wave_sum((v[0] + v[1]) + (v[2] + v[3])) * (1.0f / 256.0f); const f32x4 d = v - mean;
            const float var = wave_sum((d[0] * d[0] + d[1] * d[1]) + (d[2] * d[2] + d[3] * d[3])) * (1.0f / 256.0f);
            const float rs = __builtin_amdgcn_rsqf(var + EPS);
            const f32x4 yn = d * rs * *(const f32x4*)(lg + lane * 4) + *(const f32x4*)(lb + lane * 4);
            v2u o; o.x = pk2(yn[0] * sigm(yn[0]), yn[1] * sigm(yn[1])); o.y = pk2(yn[2] * sigm(yn[2]), yn[3] * sigm(yn[3]));
            *(v2u*)(yb + (size_t)(t0 + tok) * 256 + lane * 4) = o; }
        __syncthreads();
    }
}

constexpr int AK_ROW = 208, AV_ROW = 136, AK_BUF = 64 * AK_ROW, AV_BUF = 64 * AV_ROW;
DI void attn_phase(const Ctx& F0, const bf16* Q, const bf16* Kn, const bf16* Kr, const bf16* Vt, bf16* O) {
    Ctx F = F0; asm volatile("" : "+v"(F.tid), "+v"(F.lane));
    const int tid = F.tid, lane = F.lane, wid = F.wave, r = lane & 31, h = lane >> 5;
    LAS unsigned char* lds = F.lds;
    for (int un = F.bid; un < 1024; un += F.G) {
        const int bh = (un & 7) + 8 * (un >> 8), qb = (un >> 3) & 31, b = bh >> 3, hd = bh & 7;
        const bf16* Qp = Q + ((size_t)bh * SEQ + qb * 256 + wid * 32 + r) * 96 + h * 8;
        bf16x8 qr[6];
#pragma unroll
        for (int d0 = 0; d0 < 6; ++d0) qr[d0] = *(const bf16x8*)(Qp + d0 * 16);
        const bf16* kn_src = Kn + ((size_t)bh * SEQ + (tid >> 3)) * 64 + (tid & 7) * 8;
        const bf16* kr_src = Kr + ((size_t)b * SEQ + ((tid & 255) >> 2)) * 32 + (tid & 3) * 8;
        const bf16* v_src = Vt + ((size_t)bh * 64 + (tid >> 3)) * SEQ + (tid & 7) * 8;
        const int kn_dst = (tid >> 3) * AK_ROW + (tid & 7) * 16, kr_dst = ((tid & 255) >> 2) * AK_ROW + 128 + (tid & 3) * 16, v_dst = 2 * AK_BUF + (tid >> 3) * AV_ROW + (tid & 7) * 16;
        v4u g0, g1, g2;
        g0 = *(const v4u*)kn_src; g1 = *(const v4u*)kr_src; g2 = *(const v4u*)v_src;
        *(LAS v4u*)(lds + kn_dst) = g0; if (tid < 256) *(LAS v4u*)(lds + kr_dst) = g1;
        *(LAS v2u*)(lds + v_dst) = (v2u){g2.x, g2.y}; *(LAS v2u*)(lds + v_dst + 8) = (v2u){g2.z, g2.w};
        __syncthreads();
        f32x16 o0, o1;
#pragma unroll
        for (int i = 0; i < 16; ++i) { o0[i] = 0.f; o1[i] = 0.f; }
        float mrun = -1e30f, lrun = 0.f;
#pragma unroll 1
        for (int t = 0; t < SEQ / 64; ++t) {
            const int cur = t & 1, nxt = cur ^ 1; const bool more = (t + 1 < SEQ / 64);
            if (more) { g0 = *(const v4u*)(kn_src + (size_t)(t + 1) * 64 * 64); g1 = *(const v4u*)(kr_src + (size_t)(t + 1) * 64 * 32); g2 = *(const v4u*)(v_src + (t + 1) * 64); }
            const LAS unsigned char* kb = lds + cur * AK_BUF + r * AK_ROW + h * 16;
            const LAS unsigned char* vb = lds + 2 * AK_BUF + cur * AV_BUF + r * AV_ROW + h * 8;
            f32x16 p0, p1;
#pragma unroll
            for (int i = 0; i < 16; ++i) { p0[i] = 0.f; p1[i] = 0.f; }
#pragma unroll
            for (int d0 = 0; d0 < 6; ++d0) { const bf16x8 a0 = *(const LAS bf16x8*)(kb + d0 * 32), a1 = *(const LAS bf16x8*)(kb + 32 * AK_ROW + d0 * 32);
                p0 = __builtin_amdgcn_mfma_f32_32x32x16_bf16(a0, qr[d0], p0, 0, 0, 0); p1 = __builtin_amdgcn_mfma_f32_32x32x16_bf16(a1, qr[d0], p1, 0, 0, 0); }
            float mx = p0[0];
#pragma unroll
            for (int i = 1; i < 16; ++i) mx = fmaxf(mx, p0[i]);
#pragma unroll
            for (int i = 0; i < 16; ++i) mx = fmaxf(mx, p1[i]);
            mx = fmaxf(mx, __shfl_xor(mx, 32));
            const float mnew = fmaxf(mrun, mx), alpha = __builtin_amdgcn_exp2f(mrun - mnew); mrun = mnew;
            float ps = 0.f;
#pragma unroll
            for (int i = 0; i < 16; ++i) { p0[i] = __builtin_amdgcn_exp2f(p0[i] - mnew); p1[i] = __builtin_amdgcn_exp2f(p1[i] - mnew); ps += p0[i] + p1[i]; }
            lrun = lrun * alpha + ps;
#pragma unroll
            for (int i = 0; i < 16; ++i) { o0[i] *= alpha; o1[i] *= alpha; }
#pragma unroll
            for (int st = 0; st < 4; ++st) {
                v4u pw;
                if (st == 0) { pw.x = pk2(p0[0], p0[1]); pw.y = pk2(p0[2], p0[3]); pw.z = pk2(p0[4], p0[5]); pw.w = pk2(p0[6], p0[7]); }
                else if (st == 1) { pw.x = pk2(p0[8], p0[9]); pw.y = pk2(p0[10], p0[11]); pw.z = pk2(p0[12], p0[13]); pw.w = pk2(p0[14], p0[15]); }
                else if (st == 2) { pw.x = pk2(p1[0], p1[1]); pw.y = pk2(p1[2], p1[3]); pw.z = pk2(p1[4], p1[5]); pw.w = pk2(p1[6], p1[7]); }
                else { pw.x = pk2(p1[8], p1[9]); pw.y = pk2(p1[10], p1[11]); pw.z = pk2(p1[12], p1[13]); pw.w = pk2(p1[14], p1[15]); }
                const bf16x8 pb = __builtin_bit_cast(bf16x8, pw);
                const v2u va0 = *(const LAS v2u*)(vb + st * 32), va1 = *(const LAS v2u*)(vb + st * 32 + 16);
                const v2u vc0 = *(const LAS v2u*)(vb + 32 * AV_ROW + st * 32), vc1 = *(const LAS v2u*)(vb + 32 * AV_ROW + st * 32 + 16);
                const bf16x8 fa = __builtin_bit_cast(bf16x8, (v4u){va0.x, va0.y, va1.x, va1.y}), fc = __builtin_bit_cast(bf16x8, (v4u){vc0.x, vc0.y, vc1.x, vc1.y});
                o0 = __builtin_amdgcn_mfma_f32_32x32x16_bf16(fa, pb, o0, 0, 0, 0); o1 = __builtin_amdgcn_mfma_f32_32x32x16_bf16(fc, pb, o1, 0, 0, 0);
            }
            if (more) { *(LAS v4u*)(lds + nxt * AK_BUF + kn_dst) = g0; if (tid < 256) *(LAS v4u*)(lds + nxt * AK_BUF + kr_dst) = g1;
                *(LAS v2u*)(lds + nxt * AV_BUF + v_dst) = (v2u){g2.x, g2.y}; *(LAS v2u*)(lds + nxt * AV_BUF + v_dst + 8) = (v2u){g2.z, g2.w}; }
            __syncthreads();
        }
        const float ltot = lrun + __shfl_xor(lrun, 32), inv = 1.0f / ltot;
        bf16* Op = O + ((size_t)b * SEQ + qb * 256 + wid * 32 + r) * 512 + hd * 64 + 4 * h;
#pragma unroll
        for (int g = 0; g < 4; ++g) {
            v2u w0, w1; w0.x = pk2(o0[4 * g] * inv, o0[4 * g + 1] * inv); w0.y = pk2(o0[4 * g + 2] * inv, o0[4 * g + 3] * inv);
            w1.x = pk2(o1[4 * g] * inv, o1[4 * g + 1] * inv); w1.y = pk2(o1[4 * g + 2] * inv, o1[4 * g + 3] * inv);
            *(v2u*)(Op + 8 * g) = w0; *(v2u*)(Op + 32 + 8 * g) = w1; }
    }
}

template <class Epi> DI void run_gemm(const Ctx& F, const bf16* A, const bf16* Bt, int M, int N, int K, const Epi& E) {
    int Kv = K; asm volatile("" : "+s"(Kv)); pg8::Gemm g{A, Bt, M, N, Kv}; pg8::StaticOrder S; S.init(M, N, F.G, F.bid);
    pg8::gemm_phase<Epi, pg8::StaticOrder, true, true>((PG8_LAS unsigned char*)F.lds, g, S, E);
}

#if defined(__HIP_DEVICE_COMPILE__)
typedef const __attribute__((address_space(4))) Args* ArgsP;
DI Args load_args(ArgsP p) { asm volatile("" : "+s"(p)); Args r; const __attribute__((address_space(4))) unsigned long long* q = (const __attribute__((address_space(4))) unsigned long long*)p; unsigned long long* d = (unsigned long long*)&r;
#pragma unroll
    for (int i = 0; i < (int)(sizeof(Args) / 8); ++i) d[i] = q[i];
    return r; }
#define KERNARG_PTR() ((ArgsP)__builtin_amdgcn_kernarg_segment_ptr())
#else
typedef const Args* ArgsP;
__host__ __device__ static inline Args load_args(ArgsP p) { return *p; }
#define KERNARG_PTR() ((ArgsP)nullptr)
#endif
#define LOADARGS() const Args a = load_args(ap0); unsigned char* const ws = a.ws; bf16* const Wb = (bf16*)(ws + WS_W); bf16* const H = (bf16*)(ws + WS_H); bf16* const ACT = (bf16*)(ws + WS_ACT); bf16* const Y = (bf16*)(ws + WS_Y); float* const X = a.out; \
    const float* const mod = (const float*)(ws + WS_MOD); const float* const ng = a.in[4] + (size_t)l * 6 * DM; const float* const modl = mod + (size_t)l * 4 * NMOD * DM; (void)Wb; (void)H; (void)ACT; (void)Y; (void)X; (void)ng; (void)modl;

#define GSYNC() do { asm volatile("s_waitcnt vmcnt(0) lgkmcnt(0)" ::: "memory"); grid.sync(); __builtin_amdgcn_fence(__ATOMIC_ACQUIRE, "agent"); asm volatile("s_waitcnt vmcnt(0)" ::: "memory"); } while (0)
__global__ void __launch_bounds__(NTHR, 2) fwd_megakernel(Args a_unused) {
    extern __shared__ __attribute__((aligned(16))) unsigned char lds_raw[];
    cg::grid_group grid = cg::this_grid();
    Ctx F; F.tid = threadIdx.x; F.lane = F.tid & 63; F.wave = __builtin_amdgcn_readfirstlane(F.tid >> 6); F.G = gridDim.x; F.bid = blockIdx.x; F.lds = (LAS unsigned char*)lds_raw;
    const ArgsP ap0 = KERNARG_PTR();

    { const int l = 0; LOADARGS();
      build_tables(F, a);
      compute_mod(F, a);
      convert_weights(F, a, 0); }
    GSYNC();
    { const int l = 0; LOADARGS();
      rowwise(F, a.in[0], nullptr, 0.f, nullptr, nullptr, X, a.in[4], mod + 0 * DM, mod + 1 * DM, H, false, true); }
    GSYNC();

#pragma unroll 1
    for (int l = 0; l < DEPTH; ++l) {
#pragma unroll 1
        for (int half = 0; half < 2; ++half) {
            { LOADARGS(); pg8::EpiSwiglu E{ACT, DFF}; run_gemm(F, H, Wb + (half * W_FFN_STRIDE + W_FFN_IN) / 2, T, 2 * DFF, DM, E); }
            GSYNC();
            { LOADARGS(); pg8::EpiPlain E{Y, DM}; run_gemm(F, ACT, Wb + (half * W_FFN_STRIDE + W_FFN_OUT) / 2, T, DM, DFF, E); }
            GSYNC();
            { LOADARGS();
              if (half == 0) rowwise(F, X, Y, 0.5f, modl + 2 * DM, ng + 1 * DM, X, ng + 2 * DM, modl + 3 * DM, modl + 4 * DM, H, true, true);
              else {
                const bool nxt = (l + 1 < DEPTH);
                rowwise(F, X, Y, 0.5f, modl + 8 * DM, ng + 5 * DM, X, ng + 6 * DM, modl + 4 * NMOD * DM, modl + 4 * NMOD * DM + DM, H, true, nxt);
                if (nxt) convert_weights(F, a, l + 1);
              } }
            GSYNC();
            if (half == 0) {
                { LOADARGS(); pg8::EpiMixA E{(bf16*)(ws + WS_ZA), (bf16*)(ws + WS_U), (bf16*)(ws + WS_ZC), (bf16*)(ws + WS_ZD)}; run_gemm(F, H, Wb + W_MIXIN / 2, T, 2048, DM, E); }
                GSYNC();
                { LOADARGS(); mixer_pre(F, a, l); }
                GSYNC();
                { LOADARGS(); pg8::EpiDftC E{(bf16*)(ws + WS_ZT)}; run_gemm(F, (const bf16*)(ws + WS_WDFTC), (const bf16*)(ws + WS_ZD), 256, T * 4, 128, E); }
                { LOADARGS(); pg8::EpiQ E{(bf16*)(ws + WS_Q), (const float*)(ws + WS_COS), (const float*)(ws + WS_SIN), C2}; run_gemm(F, (const bf16*)(ws + WS_CQN), Wb + W_UQ / 2, T, 768, QLP, E); }
                { LOADARGS(); pg8::EpiK E{(bf16*)(ws + WS_KN)}; run_gemm(F, (const bf16*)(ws + WS_CKVN), Wb + W_UKV / 2, T, 512, KVL, E); }
                { LOADARGS(); pg8::EpiVt E{(bf16*)(ws + WS_VT)}; run_gemm(F, Wb + W_UKV / 2 + 512 * KVL, (const bf16*)(ws + WS_CKVN), 512, T, KVL, E); }
                GSYNC();
                { LOADARGS(); pg8::EpiFftA E{(bf16*)(ws + WS_YP), (const pg8::f32x2_t*)(ws + WS_TW)}; run_gemm(F, (const bf16*)(ws + WS_WFFTA), (const bf16*)(ws + WS_ZT), 256, T * 4, 256, E); }
                { LOADARGS(); attn_phase(F, (const bf16*)(ws + WS_Q), (const bf16*)(ws + WS_KN), (const bf16*)(ws + WS_KR), (const bf16*)(ws + WS_VT), (bf16*)(ws + WS_O)); }
                GSYNC();
                { LOADARGS(); pg8::EpiFftC E{(bf16*)(ws + WS_F)}; run_gemm(F, (const bf16*)(ws + WS_W64), (const bf16*)(ws + WS_YP), 256, T * 8, 128, E); }
                GSYNC();
                { LOADARGS(); pg8::EpiSigm E{(bf16*)(ws + WS_GATES), 4096}; run_gemm(F, H, Wb + W_MIXIN / 2 + (size_t)2048 * DM, T, 4096, DM, E); }
                GSYNC();
#pragma unroll 1
                for (int br = 0; br < 4; ++br) { LOADARGS();
                    const bf16* A = br == 0 ? (const bf16*)(ws + WS_O) : br == 1 ? (const bf16*)(ws + WS_YB) : br == 2 ? (const bf16*)(ws + WS_DP) : (const bf16*)(ws + WS_F);
                    const bf16* B = br == 0 ? Wb + W_A / 2 : br == 1 ? Wb + W_B / 2 : br == 2 ? Wb + W_C / 2 : Wb + W_D / 2;
                    pg8::EpiMerge E{H, (const bf16*)(ws + WS_GATES), br}; run_gemm(F, A, B, T, DM, br == 1 ? 256 : 512, E);
                }
                GSYNC();
                { LOADARGS(); pg8::EpiPlain E{Y, DM}; run_gemm(F, H, Wb + W_OUT / 2, T, DM, DM, E); }
                GSYNC();
                { LOADARGS(); rowwise(F, X, Y, 1.0f, modl + 5 * DM, ng + 3 * DM, X, ng + 4 * DM, modl + 6 * DM, modl + 7 * DM, H, true, true); }
                GSYNC();
            }
        }
    }
}

extern "C" void kernel_launch(void* const* d_in, const int* in_sizes, int n_in, void* d_out, int out_size, void* d_ws, size_t ws_size, hipStream_t stream) {
    static int grid = 0;
    if (grid == 0) {
        int dev = 0, cus = 0, per_cu = 0;
        hipGetDevice(&dev); hipDeviceGetAttribute(&cus, hipDeviceAttributeMultiprocessorCount, dev);
        hipFuncSetAttribute((const void*)fwd_megakernel, hipFuncAttributeMaxDynamicSharedMemorySize, LDS_BYTES);
        hipOccupancyMaxActiveBlocksPerMultiprocessor(&per_cu, (const void*)fwd_megakernel, NTHR, LDS_BYTES);
        (void)hipGetLastError();
        if (n_in != 25 || ws_size < WS_END || per_cu < 1) { fprintf(stderr, "kernel_launch: unexpected config n_in %d ws %zu per_cu %d\n", n_in, ws_size, per_cu); if (per_cu < 1) per_cu = 1; }
        grid = cus > 0 ? cus : 256;
    }
    Args a{};
    for (int i = 0; i < 25; ++i) a.in[i] = (const float*)d_in[i];
    a.out = (float*)d_out; a.ws = (unsigned char*)d_ws;
    void* args[] = {&a};
    hipError_t e = hipLaunchCooperativeKernel((const void*)fwd_megakernel, dim3(grid), dim3(NTHR), args, LDS_BYTES, stream);
    if (e != hipSuccess) fprintf(stderr, "cooperative launch failed: %s (grid %d)\n", hipGetErrorString(e), grid);
}
```

```cpp
#include <hip/hip_runtime.h>
#include <hip/hip_cooperative_groups.h>
#include <cstdio>
#include <cstdint>
namespace cg = cooperative_groups;
#ifndef DBG_MASK
#define DBG_MASK 0
#endif
namespace pg8 {
#define PG8_LAS __attribute__((address_space(3)))
typedef unsigned short bf16_t;
typedef short bf16x8 __attribute__((ext_vector_type(8)));
typedef float f32x4 __attribute__((ext_vector_type(4)));
typedef unsigned u32x4 __attribute__((ext_vector_type(4)));
constexpr int BM = 256, BK = 64, HALF = 128, HTB = HALF * BK * 2  , STAGE_BYTES = 8 * HTB, NXCD = 8, WGM = 8;

__host__ __device__ __forceinline__ int lds_byte(int r, int c) { const int st = (r >> 4) * 2 + (c >> 5), rr = r & 15, cc = c & 31, ob = rr * 64 + cc * 2; return st * 1024 + (ob ^ (((ob >> 9) & 1) << 5)); }
__host__ __device__ __forceinline__ void stage_rc(int b, int& R, int& C) { const int st = b / 1024, sb = b % 1024, swz = sb ^ (((sb >> 9) & 1) << 5); R = (st >> 1) * 16 + swz / 64; C = (st & 1) * 32 + (swz % 64) / 2; }
__host__ __device__ __forceinline__ int perm32(int rho) { const int n = rho >> 4, i = rho & 15; return 8 * (i >> 2) + 4 * n + (i & 3); }

struct Unit { int pm, pn; };
struct Gemm { const bf16_t* A; const bf16_t* Bt; int M, N, K; };

struct StaticOrder {
    int nM, nN, nwg, G, c;
    __host__ __device__ void init(int M, int N, int G_, int c_) { nM = M / BM; nN = N / BM; nwg = nM * nN; G = G_; c = c_; }
    __host__ __device__ bool next(int i, Unit& u) const {
        const long L = (long)i * G + c; if (L >= nwg) return false;
        int wgid = (int)L; { const int q = nwg / NXCD, r = nwg % NXCD, xcd = wgid % NXCD, off = wgid / NXCD; wgid = (xcd < r ? xcd * (q + 1) : r * (q + 1) + (xcd - r) * q) + off; }
        const int nig = WGM * nN, gid = wgid / nig, fm = gid * WGM, gsz = (nM - fm) < WGM ? (nM - fm) : WGM;
        u.pm = fm + ((wgid % nig) % gsz); u.pn = (wgid % nig) / gsz; return true;
    }
    __device__ __forceinline__ void a_ready(const Unit&) const {}
    __device__ __forceinline__ void done(const Unit&) const {}
};

typedef float f32x2_t __attribute__((ext_vector_type(2))); typedef __bf16 bf16x2_t __attribute__((ext_vector_type(2)));
typedef unsigned u32x2 __attribute__((ext_vector_type(2)));
__device__ __forceinline__ unsigned pk2(float lo, float hi) { f32x2_t v = {lo, hi}; bf16x2_t b = __builtin_convertvector(v, bf16x2_t); return __builtin_bit_cast(unsigned, b); }
__device__ __forceinline__ u32x4 pack8(f32x4 a, f32x4 b) { u32x4 w; w.x = pk2(a[0], a[1]); w.y = pk2(a[2], a[3]); w.z = pk2(b[0], b[1]); w.w = pk2(b[2], b[3]); return w; }
__device__ __forceinline__ u32x2 pack4(f32x4 a) { u32x2 w; w.x = pk2(a[0], a[1]); w.y = pk2(a[2], a[3]); return w; }
__device__ __forceinline__ float bflo(unsigned u) { return __uint_as_float(u << 16); }
__device__ __forceinline__ float bfhi(unsigned u) { return __uint_as_float(u & 0xffff0000u); }
__device__ __forceinline__ float sigm(float x) { return __builtin_amdgcn_rcpf(1.0f + __expf(-x)); }
__device__ __forceinline__ f32x4 sigm4(f32x4 v) { f32x4 o; o[0] = sigm(v[0]); o[1] = sigm(v[1]); o[2] = sigm(v[2]); o[3] = sigm(v[3]); return o; }

struct EpiPlain {
    static constexpr bool PERM = true, AFTER_DRAIN = false;
    bf16_t* O; int ldc;
    __device__ __forceinline__ void operator()(const f32x4 (&acc)[2][2][4][2], const Unit& u, int wr, int wc, int fr, int fq) const {
        const int row0 = u.pm * BM + wr * 64 + fr, col0 = u.pn * BM + wc * 32 + 8 * fq;
#pragma unroll
        for (int ai = 0; ai < 2; ++ai)
#pragma unroll
            for (int m = 0; m < 4; ++m) { asm volatile("" ::: "memory"); bf16_t* rowp = O + (size_t)(row0 + ai * HALF + m * 16) * ldc + col0;
#pragma unroll
                for (int bj = 0; bj < 2; ++bj) *(u32x4*)(rowp + bj * HALF) = pack8(acc[ai][bj][m][0], acc[ai][bj][m][1]); }
    }
};
struct EpiSigm {
    static constexpr bool PERM = true, AFTER_DRAIN = false;
    bf16_t* O; int ldc;
    __device__ __forceinline__ void operator()(const f32x4 (&acc)[2][2][4][2], const Unit& u, int wr, int wc, int fr, int fq) const {
        const int row0 = u.pm * BM + wr * 64 + fr, col0 = u.pn * BM + wc * 32 + 8 * fq;
#pragma unroll
        for (int ai = 0; ai < 2; ++ai)
#pragma unroll
            for (int m = 0; m < 4; ++m) { asm volatile("" ::: "memory"); bf16_t* rowp = O + (size_t)(row0 + ai * HALF + m * 16) * ldc + col0;
#pragma unroll
                for (int bj = 0; bj < 2; ++bj) *(u32x4*)(rowp + bj * HALF) = pack8(sigm4(acc[ai][bj][m][0]), sigm4(acc[ai][bj][m][1])); }
    }
};
struct EpiSwiglu {
    static constexpr bool PERM = true, AFTER_DRAIN = false;
    bf16_t* O; int ldc;
    __device__ __forceinline__ void operator()(const f32x4 (&acc)[2][2][4][2], const Unit& u, int wr, int wc, int fr, int fq) const {
        const int row0 = u.pm * BM + wr * 64 + fr, col0 = u.pn * HALF + wc * 32 + 8 * fq;
#pragma unroll
        for (int ai = 0; ai < 2; ++ai)
#pragma unroll
            for (int m = 0; m < 4; ++m) { asm volatile("" ::: "memory"); bf16_t* rowp = O + (size_t)(row0 + ai * HALF + m * 16) * ldc + col0;
                const f32x4 g0 = acc[ai][0][m][0], g1 = acc[ai][0][m][1], u0 = acc[ai][1][m][0], u1 = acc[ai][1][m][1];
                *(u32x4*)rowp = pack8(g0 * sigm4(g0) * u0, g1 * sigm4(g1) * u1); }
    }
};
struct EpiMixA {
    static constexpr bool PERM = true, AFTER_DRAIN = false;
    bf16_t *ZA, *U, *ZC, *ZD;
    __device__ __forceinline__ void operator()(const f32x4 (&acc)[2][2][4][2], const Unit& u, int wr, int wc, int fr, int fq) const {
        const int row0 = u.pm * BM + wr * 64 + fr, cw = wc * 32 + 8 * fq; const int pn = u.pn;
#pragma unroll
        for (int ai = 0; ai < 2; ++ai)
#pragma unroll
            for (int m = 0; m < 4; ++m) { asm volatile("" ::: "memory"); const int row = row0 + ai * HALF + m * 16;
                if (pn < 2) { bf16_t* p = ZA + (size_t)row * 512 + pn * 256 + cw;
                    *(u32x4*)p = pack8(acc[ai][0][m][0], acc[ai][0][m][1]); *(u32x4*)(p + HALF) = pack8(acc[ai][1][m][0], acc[ai][1][m][1]); }
                else if (pn < 4) { bf16_t* p = U + (size_t)row * 256 + (pn - 2) * HALF + cw;
                    *(u32x4*)p = pack8(acc[ai][0][m][0] * sigm4(acc[ai][1][m][0]), acc[ai][0][m][1] * sigm4(acc[ai][1][m][1])); }
                else if (pn < 6) { bf16_t* p = ZC + (size_t)row * 512 + (pn - 4) * 256 + cw;
                    *(u32x4*)p = pack8(acc[ai][0][m][0], acc[ai][0][m][1]); *(u32x4*)(p + HALF) = pack8(acc[ai][1][m][0], acc[ai][1][m][1]); }
                else { const int b = row >> 13, s = row & 8191, s1 = s >> 6, s2 = s & 63;
#pragma unroll
                    for (int bj = 0; bj < 2; ++bj) { const int cz = (pn - 6) * 256 + bj * HALF + cw, g = cz >> 7, c = cz & 127;
                        bf16_t* p = ZD + ((size_t)(((b * 64 + s2) * 4 + g) * 128 + s1)) * 128 + c;
                        *(u32x4*)p = pack8(acc[ai][bj][m][0], acc[ai][bj][m][1]); } }
            }
    }
};
struct EpiQ {
    static constexpr bool PERM = false, AFTER_DRAIN = false;
    bf16_t* Q; const float* cosT; const float* sinT; float c2;
    __device__ __forceinline__ void operator()(const f32x4 (&acc)[2][2][4][2], const Unit& u, int wr, int wc, int fr, int fq) const {
        const int row0 = u.pm * BM + wr * 64 + fr;
#pragma unroll
        for (int bj = 0; bj < 2; ++bj) { const int g32 = u.pn * 8 + bj * 4 + wc, head = g32 / 3, part = g32 - head * 3;
#pragma unroll
            for (int ai = 0; ai < 2; ++ai)
#pragma unroll
                for (int m = 0; m < 4; ++m) { asm volatile("" ::: "memory"); const int row = row0 + ai * HALF + m * 16, b = row >> 13, s = row & 8191;
                    bf16_t* p = Q + ((size_t)((b * 8 + head) * 8192 + s)) * 96 + part * 32 + 4 * fq;
                    f32x4 x1 = acc[ai][bj][m][0], x2 = acc[ai][bj][m][1];
                    if (part == 2) { const f32x4 c = *(const f32x4*)(cosT + s * 16 + 4 * fq), sn = *(const f32x4*)(sinT + s * 16 + 4 * fq);
                        const f32x4 o1 = x1 * c - x2 * sn, o2 = x1 * sn + x2 * c; x1 = o1; x2 = o2; }
                    *(u32x2*)p = pack4(x1 * c2); *(u32x2*)(p + 16) = pack4(x2 * c2); }
        }
    }
};
struct EpiK {
    static constexpr bool PERM = true, AFTER_DRAIN = false;
    bf16_t* Kn;
    __device__ __forceinline__ void operator()(const f32x4 (&acc)[2][2][4][2], const Unit& u, int wr, int wc, int fr, int fq) const {
        const int row0 = u.pm * BM + wr * 64 + fr;
#pragma unroll
        for (int bj = 0; bj < 2; ++bj) { const int col = u.pn * BM + bj * HALF + wc * 32 + 8 * fq, hd = col >> 6, c = col & 63;
#pragma unroll
            for (int ai = 0; ai < 2; ++ai)
#pragma unroll
                for (int m = 0; m < 4; ++m) { asm volatile("" ::: "memory"); const int row = row0 + ai * HALF + m * 16, b = row >> 13, s = row & 8191;
                    *(u32x4*)(Kn + ((size_t)((b * 8 + hd) * 8192 + s)) * 64 + c) = pack8(acc[ai][bj][m][0], acc[ai][bj][m][1]); }
        }
    }
};
struct EpiVt {
    static constexpr bool PERM = true, AFTER_DRAIN = false;
    bf16_t* Vt;
    __device__ __forceinline__ void operator()(const f32x4 (&acc)[2][2][4][2], const Unit& u, int wr, int wc, int fr, int fq) const {
        const int row0 = u.pm * BM + wr * 64 + fr;
#pragma unroll
        for (int bj = 0; bj < 2; ++bj) { const int t0 = u.pn * BM + bj * HALF + wc * 32 + 8 * fq, b = t0 >> 13, s = t0 & 8191;
#pragma unroll
            for (int ai = 0; ai < 2; ++ai)
#pragma unroll
                for (int m = 0; m < 4; ++m) { asm volatile("" ::: "memory"); const int row = row0 + ai * HALF + m * 16;
                    *(u32x4*)(Vt + ((size_t)(b * 512 + row)) * 8192 + s) = pack8(acc[ai][bj][m][0], acc[ai][bj][m][1]); }
        }
    }
};
struct EpiDftC {
    static constexpr bool PERM = true, AFTER_DRAIN = false;
    bf16_t* Zt;
    __device__ __forceinline__ void operator()(const f32x4 (&acc)[2][2][4][2], const Unit& u, int wr, int wc, int fr, int fq) const {
#pragma unroll
        for (int bj = 0; bj < 2; ++bj) { const int n = u.pn * BM + bj * HALF + wc * 32 + 8 * fq, s1 = n & 127, g = (n >> 7) & 3, s2 = (n >> 9) & 63, b = n >> 15;
#pragma unroll
            for (int ai = 0; ai < 2; ++ai)
#pragma unroll
                for (int m = 0; m < 4; ++m) { asm volatile("" ::: "memory"); const int kc = wr * 64 + m * 16 + fr;
                    *(u32x4*)(Zt + ((size_t)(((b * 4 + g) * 128 + kc) * 64 + s2)) * 256 + ai * 128 + s1) = pack8(acc[ai][bj][m][0], acc[ai][bj][m][1]); }
        }
    }
};
struct EpiFftA {
    static constexpr bool PERM = true, AFTER_DRAIN = false;
    bf16_t* Yp; const f32x2_t* tw;
    __device__ __forceinline__ void operator()(const f32x4 (&acc)[2][2][4][2], const Unit& u, int wr, int wc, int fr, int fq) const {
#pragma unroll
        for (int bj = 0; bj < 2; ++bj) { const int n = u.pn * BM + bj * HALF + wc * 32 + 8 * fq, s2 = n & 63, rest = n >> 6, kc = rest & 127, bg = rest >> 7, b = bg >> 2, g = bg & 3;
#pragma unroll
            for (int m = 0; m < 4; ++m) { asm volatile("" ::: "memory"); int k1 = wr * 64 + m * 16 + fr; asm volatile("" : "+v"(k1));
                bf16_t* p = Yp + ((size_t)(((b * 128 + k1) * 4 + g) * 128 + kc)) * 128 + s2;
#pragma unroll
                for (int hv = 0; hv < 2; ++hv) { f32x4 rr, ii;
#pragma unroll
                    for (int e = 0; e < 4; ++e) { const f32x2_t t0 = tw[k1 * (s2 + 4 * hv + e)]; const float yr = acc[0][bj][m][hv][e], yi = acc[1][bj][m][hv][e];
                        rr[e] = yr * t0.x + yi * t0.y; ii[e] = yi * t0.x - yr * t0.y; }
                    *(u32x2*)(p + 4 * hv) = pack4(rr); *(u32x2*)(p + 64 + 4 * hv) = pack4(ii); asm volatile("" ::: "memory"); }
            }
        }
    }
};
struct EpiFftC {
    static constexpr bool PERM = true, AFTER_DRAIN = false;
    bf16_t* F;
    __device__ __forceinline__ void operator()(const f32x4 (&acc)[2][2][4][2], const Unit& u, int wr, int wc, int fr, int fq) const {
        if (wr != 0) return;
#pragma unroll
        for (int bj = 0; bj < 2; ++bj) { const int n = u.pn * BM + bj * HALF + wc * 32 + 8 * fq, kc = n & 127, g = (n >> 7) & 3, k1 = (n >> 9) & 127, b = n >> 16;
#pragma unroll
            for (int m = 0; m < 4; ++m) { asm volatile("" ::: "memory"); const int k2 = m * 16 + fr;
                *(u32x4*)(F + ((size_t)(b * 8192 + k1 + 128 * k2)) * 512 + g * 128 + kc) = pack8(acc[0][bj][m][0], acc[0][bj][m][1]); }
        }
    }
};
struct EpiMerge {
    static constexpr bool PERM = true, AFTER_DRAIN = false;
    bf16_t* Mg; const bf16_t* G; int br;
    __device__ __forceinline__ void operator()(const f32x4 (&acc)[2][2][4][2], const Unit& u, int wr, int wc, int fr, int fq) const {
        const int row0 = u.pm * BM + wr * 64 + fr, col0 = u.pn * BM + wc * 32 + 8 * fq;
#pragma unroll
        for (int ai = 0; ai < 2; ++ai)
#pragma unroll
            for (int m = 0; m < 4; ++m) { asm volatile("" ::: "memory"); const int row = row0 + ai * HALF + m * 16;
#pragma unroll
                for (int bj = 0; bj < 2; ++bj) { const int col = col0 + bj * HALF;
                    const u32x4 gw = *(const u32x4*)(G + (size_t)row * 4096 + br * 1024 + col);
                    f32x4 v0 = acc[ai][bj][m][0], v1 = acc[ai][bj][m][1];
                    if ((DBG_MASK >> br) & 1) { v0 = v0 * 0.f; v1 = v1 * 0.f; }
                    v0[0] *= bflo(gw.x); v0[1] *= bfhi(gw.x); v0[2] *= bflo(gw.y); v0[3] *= bfhi(gw.y); v1[0] *= bflo(gw.z); v1[1] *= bfhi(gw.z); v1[2] *= bflo(gw.w); v1[3] *= bfhi(gw.w);
                    bf16_t* p = Mg + (size_t)row * 1024 + col;
                    if (br > 0) { const u32x4 o = *(const u32x4*)p;
                        v0[0] += bflo(o.x); v0[1] += bfhi(o.x); v0[2] += bflo(o.y); v0[3] += bfhi(o.y); v1[0] += bflo(o.z); v1[1] += bfhi(o.z); v1[2] += bflo(o.w); v1[3] += bfhi(o.w); }
                    *(u32x4*)p = pack8(v0, v1); }
            }
    }
};

template <class Epi, class Sched, bool ALIGN_EPI = false, bool SP2 = false>
__device__ __forceinline__ void gemm_phase(PG8_LAS unsigned char* lds, const Gemm g, const Sched& S, const Epi& E) {
    int tid_ = threadIdx.x; asm volatile("" : "+v"(tid_)); const int tid = tid_, wid = __builtin_amdgcn_readfirstlane(tid >> 6), lane = tid & 63, wr = wid >> 2, wc = wid & 3, fr = lane & 15, fq = lane >> 4;
    const int K = g.K, nt = K / BK;
    unsigned voffA[2], voffB[2];
#pragma unroll
    for (int i = 0; i < 2; ++i) { int R, C; stage_rc(tid * 16 + i * 8192, R, C); const int Rb = Epi::PERM ? ((R & ~31) + perm32(R & 31)) : R;
        voffA[i] = (unsigned)(R * K + C) * 2u; voffB[i] = (unsigned)(Rb * K + C) * 2u; }
    const size_t kstep = (size_t)(BK * 2);
    const size_t hstep = (size_t)HALF * K * 2;
    const size_t tstep = 2 * hstep;
    const unsigned ldsw = (unsigned)wid * 1024u;
    const int aoff = lds_byte(wr * 64 + fr, fq * 8), boff = lds_byte(wc * 32 + fr, fq * 8);
#define PG8_SA(b, h) (((b) * 2 + (h)) * HTB)
#define PG8_SB(b, h) ((4 + (b) * 2 + (h)) * HTB)
#define PG8_STAGE(bufoff, gbase, voff) do { _Pragma("unroll") for (int _i = 0; _i < 2; ++_i) \
        __builtin_amdgcn_global_load_lds((const unsigned*)((const char*)(gbase) + (voff)[_i]), (PG8_LAS unsigned*)(lds + (bufoff) + ldsw + _i * 8192), 16, 0, 0); } while (0)
#define PG8_LDA(dst, b, h) do { _Pragma("unroll") for (int m = 0; m < 4; ++m) _Pragma("unroll") for (int k = 0; k < 2; ++k) dst[m][k] = *(const PG8_LAS bf16x8*)(lds + PG8_SA(b, h) + aoff + m * 2048 + k * 1024); } while (0)
#define PG8_LDB(dst, b, h) do { _Pragma("unroll") for (int n = 0; n < 2; ++n) _Pragma("unroll") for (int k = 0; k < 2; ++k) dst[n][k] = *(const PG8_LAS bf16x8*)(lds + PG8_SB(b, h) + boff + n * 2048 + k * 1024); } while (0)
#define PG8_MMA(ai, bj, At, Bt) do { __builtin_amdgcn_s_setprio(1); _Pragma("unroll") for (int m = 0; m < 4; ++m) _Pragma("unroll") for (int n = 0; n < 2; ++n) _Pragma("unroll") for (int k = 0; k < 2; ++k) \
        acc[ai][bj][m][n] = __builtin_amdgcn_mfma_f32_16x16x32_bf16(Bt[n][k], At[m][k], acc[ai][bj][m][n], 0, 0, 0); __builtin_amdgcn_s_setprio(0); } while (0)
#define PG8_WAIT_V(n) asm volatile("s_waitcnt vmcnt(" #n ")" ::: "memory")
#define PG8_WAIT_L(n) asm volatile("s_waitcnt lgkmcnt(" #n ")" ::: "memory")
#define PG8_BAR __builtin_amdgcn_s_barrier()
#define PG8_SCHED __builtin_amdgcn_sched_barrier(0)
    Unit cur, nxt; int ui = 0;
    if (!S.next(0, cur)) return;
    f32x4 acc[2][2][4][2];
#pragma unroll
    for (int a = 0; a < 2; ++a)
#pragma unroll
        for (int b = 0; b < 2; ++b)
#pragma unroll
            for (int m = 0; m < 4; ++m)
#pragma unroll
                for (int n = 0; n < 2; ++n) acc[a][b][m][n] = (f32x4){0.f, 0.f, 0.f, 0.f};
    bf16x8 At[4][2], B0[2][2], B1[2][2];
    const char* cA = (const char*)g.A + (size_t)cur.pm * tstep; const char* cB = (const char*)g.Bt + (size_t)cur.pn * tstep;
    S.a_ready(cur);
    if constexpr (SP2) {
        PG8_STAGE(PG8_SB(0, 0), cB, voffB); PG8_STAGE(PG8_SB(0, 1), cB + hstep, voffB); PG8_STAGE(PG8_SA(0, 0), cA, voffA); PG8_STAGE(PG8_SA(0, 1), cA + hstep, voffA);
        if (wr == 1) PG8_BAR;
        PG8_WAIT_V(2); PG8_BAR;
        PG8_STAGE(PG8_SB(1, 0), cB + kstep, voffB); PG8_STAGE(PG8_SA(1, 0), cA + kstep, voffA); PG8_STAGE(PG8_SB(1, 1), cB + hstep + kstep, voffB);
        PG8_WAIT_V(6); PG8_BAR;
    } else {
        PG8_STAGE(PG8_SB(0, 0), cB, voffB); PG8_STAGE(PG8_SA(0, 0), cA, voffA); PG8_STAGE(PG8_SB(0, 1), cB + hstep, voffB); PG8_STAGE(PG8_SA(0, 1), cA + hstep, voffA);
        if (wr == 1) PG8_BAR;
        PG8_WAIT_V(4); PG8_BAR;
        PG8_STAGE(PG8_SB(1, 0), cB + kstep, voffB); PG8_STAGE(PG8_SA(1, 0), cA + kstep, voffA); PG8_STAGE(PG8_SB(1, 1), cB + hstep + kstep, voffB);
        PG8_WAIT_V(6); PG8_BAR;
    }
    for (;;) {
        const bool has_next = S.next(ui + 1, nxt);
        const char* nA = has_next ? (const char*)g.A + (size_t)nxt.pm * tstep : cA; const char* nB = has_next ? (const char*)g.Bt + (size_t)nxt.pn * tstep : cB;
        for (int t = 0; t < nt; t += 2) {
            const bool last = (t == nt - 2);
            const char* a1 = cA + (size_t)(t + 1) * kstep;
            const char* a2 = last ? nA : cA + (size_t)(t + 2) * kstep; const char* b2 = last ? nB : cB + (size_t)(t + 2) * kstep;
            const char* a3 = a2 + kstep; const char* b3 = b2 + kstep;
            if (last && has_next) S.a_ready(nxt);
            if constexpr (SP2) {
            PG8_LDB(B0, 0, 0); PG8_LDB(B1, 0, 1); PG8_SCHED; PG8_LDA(At, 0, 0); PG8_STAGE(PG8_SA(1, 1), a1 + hstep, voffA);
            PG8_WAIT_V(8); PG8_WAIT_L(0); PG8_BAR; PG8_MMA(0, 0, At, B0); PG8_MMA(0, 1, At, B1); PG8_BAR; PG8_SCHED;
            PG8_LDA(At, 0, 1); PG8_STAGE(PG8_SB(0, 0), b2, voffB); PG8_STAGE(PG8_SB(0, 1), b2 + hstep, voffB); PG8_STAGE(PG8_SA(0, 0), a2, voffA);
            PG8_WAIT_V(8); PG8_WAIT_L(0); PG8_BAR; PG8_MMA(1, 0, At, B0); PG8_MMA(1, 1, At, B1); PG8_BAR; PG8_SCHED;
            PG8_LDB(B0, 1, 0); PG8_LDB(B1, 1, 1); PG8_SCHED; PG8_LDA(At, 1, 0); PG8_STAGE(PG8_SA(0, 1), a2 + hstep, voffA);
            PG8_WAIT_V(8); PG8_WAIT_L(0); PG8_BAR; PG8_MMA(0, 0, At, B0); PG8_MMA(0, 1, At, B1); PG8_BAR; PG8_SCHED;
            PG8_LDA(At, 1, 1); PG8_STAGE(PG8_SB(1, 0), b3, voffB); PG8_STAGE(PG8_SB(1, 1), b3 + hstep, voffB); PG8_STAGE(PG8_SA(1, 0), a3, voffA);
            PG8_WAIT_V(8); PG8_WAIT_L(0); PG8_BAR; PG8_MMA(1, 0, At, B0); PG8_MMA(1, 1, At, B1); PG8_BAR; PG8_SCHED;
            } else {
            PG8_LDB(B0, 0, 0); PG8_SCHED; PG8_LDA(At, 0, 0); PG8_STAGE(PG8_SA(1, 1), a1 + hstep, voffA);
            PG8_WAIT_L(8); PG8_BAR; PG8_WAIT_L(0); PG8_MMA(0, 0, At, B0); PG8_BAR; PG8_SCHED;
            PG8_LDB(B1, 0, 1); PG8_STAGE(PG8_SB(0, 0), b2, voffB);
            PG8_BAR; PG8_WAIT_L(0); PG8_MMA(0, 1, At, B1); PG8_BAR;
            PG8_LDA(At, 0, 1); PG8_STAGE(PG8_SA(0, 0), a2, voffA);
            PG8_BAR; PG8_WAIT_L(0); PG8_MMA(1, 0, At, B0); PG8_BAR; PG8_SCHED;
            PG8_STAGE(PG8_SB(0, 1), b2 + hstep, voffB);
            PG8_WAIT_V(6); PG8_BAR; PG8_MMA(1, 1, At, B1); PG8_BAR;
            PG8_LDB(B0, 1, 0); PG8_SCHED; PG8_LDA(At, 1, 0); PG8_STAGE(PG8_SA(0, 1), a2 + hstep, voffA);
            PG8_WAIT_L(8); PG8_BAR; PG8_WAIT_L(0); PG8_MMA(0, 0, At, B0); PG8_BAR; PG8_SCHED;
            PG8_LDB(B1, 1, 1); PG8_STAGE(PG8_SB(1, 0), b3, voffB);
            PG8_BAR; PG8_WAIT_L(0); PG8_MMA(0, 1, At, B1); PG8_BAR;
            PG8_LDA(At, 1, 1); PG8_STAGE(PG8_SA(1, 0), a3, voffA);
            PG8_BAR; PG8_WAIT_L(0); PG8_MMA(1, 0, At, B0); PG8_BAR; PG8_SCHED;
            PG8_STAGE(PG8_SB(1, 1), b3 + hstep, voffB);
            PG8_WAIT_V(6); PG8_BAR; PG8_MMA(1, 1, At, B1); PG8_BAR;
            }
        }
        if constexpr (ALIGN_EPI) { if (wr == 0) PG8_BAR; }
        if constexpr (!Epi::AFTER_DRAIN) { E(acc, cur, wr, wc, fr, fq); S.done(cur); }
        if (!has_next) break;
#pragma unroll
        for (int a = 0; a < 2; ++a)
#pragma unroll
            for (int b = 0; b < 2; ++b)
#pragma unroll
                for (int m = 0; m < 4; ++m)
#pragma unroll
                    for (int n = 0; n < 2; ++n) acc[a][b][m][n] = (f32x4){0.f, 0.f, 0.f, 0.f};
        cur = nxt; cA = nA; cB = nB; ++ui;
        if constexpr (ALIGN_EPI) { if (wr == 1) PG8_BAR; }
    }
    PG8_WAIT_V(0);
    if constexpr (!ALIGN_EPI) { if (wr == 0) PG8_BAR; }
    PG8_BAR;
    if constexpr (Epi::AFTER_DRAIN) { E.fused(acc, cur, wr, wc, fr, fq, lds, wid, lane); S.done(cur); }
#undef PG8_SA
#undef PG8_SB
#undef PG8_STAGE
#undef PG8_LDA
#undef PG8_LDB
#undef PG8_MMA
#undef PG8_WAIT_V
#undef PG8_WAIT_L
#undef PG8_BAR
#undef PG8_SCHED
}
}

#define DI __device__ __forceinline__
#define LAS __attribute__((address_space(3)))
typedef unsigned short bf16;
typedef unsigned v4u __attribute__((ext_vector_type(4)));
typedef unsigned v2u __attribute__((ext_vector_type(2)));
typedef float f32x4 __attribute__((ext_vector_type(4)));
typedef float f32x16 __attribute__((ext_vector_type(16)));
typedef short bf16x8 __attribute__((ext_vector_type(8)));
typedef short s16x4 __attribute__((ext_vector_type(4)));
using pg8::pk2; using pg8::bflo; using pg8::bfhi; using pg8::sigm;

constexpr int NWAVES = 8, NTHR = 512;
constexpr int DM = 1024, BATCH = 4, SEQ = 8192, T = BATCH * SEQ, DEPTH = 2, DFF = 2816;
constexpr int QL = 352, QLP = 384, KVL = 128, WIN = 6144, NMOD = 9;
constexpr float EPS = 1e-6f;
constexpr float C2 = 0.10206207261596577f * 1.4426950408889634f;
constexpr int LDS_BYTES = 131072 + 1024;

constexpr size_t MiB = 1u << 20;
constexpr size_t WS_MOD = 0;
constexpr size_t WS_COS = 512 * 1024, WS_SIN = 1 * MiB;
constexpr size_t WS_TW = 1536 * 1024;
constexpr size_t WS_WDFTC = 1792 * 1024;
constexpr size_t WS_WFFTA = 2 * MiB;
constexpr size_t WS_W64 = 2 * MiB + 256 * 1024;
constexpr size_t WS_W = 4 * MiB;
constexpr size_t W_FFN_IN = 0, W_FFN_OUT = 11 * MiB, W_FFN_STRIDE = 16 * MiB + 512 * 1024;
constexpr size_t W_MIXIN = 33 * MiB;
constexpr size_t W_UQ = 45 * MiB;
constexpr size_t W_UKV = 45 * MiB + 640 * 1024;
constexpr size_t W_A = 46 * MiB, W_B = 47 * MiB, W_C = 47 * MiB + 512 * 1024, W_D = 48 * MiB + 512 * 1024, W_OUT = 49 * MiB + 512 * 1024;
constexpr size_t WS_H = 56 * MiB;
constexpr size_t WS_O = 120 * MiB, WS_YB = 152 * MiB, WS_DP = 168 * MiB, WS_F = 200 * MiB;
constexpr size_t WS_TMP = 232 * MiB;
constexpr size_t WS_ACT = WS_TMP, WS_Y = 408 * MiB;
constexpr size_t WS_ZA = 232 * MiB, WS_U = 264 * MiB, WS_ZC = 280 * MiB, WS_ZD = 312 * MiB, WS_CQN = 344 * MiB, WS_CKVN = 368 * MiB, WS_KR = 376 * MiB;
constexpr size_t WS_Q = 380 * MiB, WS_KN = 428 * MiB, WS_VT = 460 * MiB;
constexpr size_t WS_ZT = 232 * MiB, WS_YP = 296 * MiB, WS_GATES = 232 * MiB;
constexpr size_t WS_END = 512 * MiB;

struct Args { const float* in[25]; float* out; unsigned char* ws; };

struct Ctx { int tid, lane, wave, G, bid; LAS unsigned char* lds; };

DI float wave_sum(float v) {
#pragma unroll
    for (int o = 1; o < 64; o <<= 1) v += __shfl_xor(v, o);
    return v;
}
DI void sincos_turns(double turns, float& sn, float& cs) {
    const double r = turns - __builtin_rint(turns);
    const double x = r * 6.283185307179586476925287, x2 = x * x;
    double ts = x, tc = 1.0, s = x, c = 1.0;
#pragma unroll 1
    for (int k = 1; k <= 14; ++k) { tc = -tc * x2 / (double)((2 * k - 1) * (2 * k)); c += tc; ts = -ts * x2 / (double)((2 * k) * (2 * k + 1)); s += ts; }
    sn = (float)s; cs = (float)c;
}

DI void transpose_item(const float* W, int Kreal, int N, bf16* WT, int Kpad, int mode, LAS float* scr, int item, int lane) {
    const int nblk = N / 32, kb = item / nblk, nb = item % nblk, k0 = 64 * kb, n0 = 32 * nb;
#pragma unroll 8
    for (int i = 0; i < 32; ++i) { const int kk = 2 * i + (lane >> 5); scr[kk * 33 + (lane & 31)] = (k0 + kk < Kreal) ? W[(size_t)(k0 + kk) * N + n0 + (lane & 31)] : 0.f; }
    asm volatile("s_waitcnt lgkmcnt(0)" ::: "memory");
    int r0;
    if (mode == 1) { const int half = N / 2; const int j = n0 >= half ? n0 - half : n0; r0 = (j >> 7) * 256 + (n0 >= half ? 128 : 0) + (j & 127); }
    else if (mode == 2) { if (n0 >= 512 && n0 < 1024) { const int j = (n0 - 512) & 255, gt = (n0 - 512) >> 8; r0 = 512 + (j >> 7) * 256 + gt * 128 + (j & 127); } else r0 = n0; }
    else if (mode == 3) { const int hd = n0 >> 7, c = n0 & 127; r0 = (c >= 64 ? 512 : 0) + hd * 64 + (c & 63); }
    else r0 = n0;
    const int c = lane & 7;
#pragma unroll
    for (int j = 0; j < 4; ++j) { const int n = (lane >> 3) + 8 * j; const LAS float* s = scr + (8 * c) * 33 + n;
        v4u o; o.x = pk2(s[0 * 33], s[1 * 33]); o.y = pk2(s[2 * 33], s[3 * 33]); o.z = pk2(s[4 * 33], s[5 * 33]); o.w = pk2(s[6 * 33], s[7 * 33]);
        *(v4u*)(WT + (size_t)(r0 + n) * Kpad + k0 + 8 * c) = o; }
    asm volatile("s_waitcnt lgkmcnt(0)" ::: "memory");
}

DI void convert_weights(const Ctx& F0, const Args& a, int l) {
    Ctx F = F0; asm volatile("" : "+v"(F.tid), "+v"(F.lane));
    LAS float* scr = (LAS float*)(F.lds + F.wave * 16384);
    bf16* Wb = (bf16*)(a.ws + WS_W);
    const int gw = F.bid * NWAVES + F.wave, NGW = F.G * NWAVES;
    constexpr int I_FI = 16 * 176, I_FO = 44 * 32, I_MI = 16 * 192, I_UQ = 6 * 24, I_UKV = 2 * 32, I_A = 8 * 32, I_B = 4 * 32, I_D = 8 * 32, I_O = 16 * 32;
    constexpr int NITEMS = 2 * I_FI + 2 * I_FO + I_MI + I_UQ + I_UKV + I_A + I_B + I_D + I_O;
    for (int it = gw; it < NITEMS; it += NGW) {
        int r = it;
        if (r < I_FI) { transpose_item(a.in[5] + (size_t)l * DM * 2 * DFF, DM, 2 * DFF, Wb + (W_FFN_IN) / 2, DM, 1, scr, r, F.lane); continue; } r -= I_FI;
        if (r < I_FI) { transpose_item(a.in[7] + (size_t)l * DM * 2 * DFF, DM, 2 * DFF, Wb + (W_FFN_STRIDE + W_FFN_IN) / 2, DM, 1, scr, r, F.lane); continue; } r -= I_FI;
        if (r < I_FO) { transpose_item(a.in[6] + (size_t)l * DFF * DM, DFF, DM, Wb + (W_FFN_OUT) / 2, DFF, 0, scr, r, F.lane); continue; } r -= I_FO;
        if (r < I_FO) { transpose_item(a.in[8] + (size_t)l * DFF * DM, DFF, DM, Wb + (W_FFN_STRIDE + W_FFN_OUT) / 2, DFF, 0, scr, r, F.lane); continue; } r -= I_FO;
        if (r < I_MI) { transpose_item(a.in[9] + (size_t)l * DM * WIN, DM, WIN, Wb + W_MIXIN / 2, DM, 2, scr, r, F.lane); continue; } r -= I_MI;
        if (r < I_UQ) { transpose_item(a.in[11] + (size_t)l * QL * 768, QL, 768, Wb + W_UQ / 2, QLP, 0, scr, r, F.lane); continue; } r -= I_UQ;
        if (r < I_UKV) { transpose_item(a.in[13] + (size_t)l * KVL * 1024, KVL, 1024, Wb + W_UKV / 2, KVL, 3, scr, r, F.lane); continue; } r -= I_UKV;
        if (r < I_A) { transpose_item(a.in[14] + (size_t)l * 512 * DM, 512, DM, Wb + W_A / 2, 512, 0, scr, r, F.lane); continue; } r -= I_A;
        if (r < I_B) { transpose_item(a.in[19] + (size_t)l * 256 * DM, 256, DM, Wb + W_B / 2, 256, 0, scr, r, F.lane); continue; } r -= I_B;
        if (r < I_D) { transpose_item(a.in[23] + (size_t)l * 512 * DM, 512, DM, Wb + W_D / 2, 512, 0, scr, r, F.lane); continue; } r -= I_D;
        transpose_item(a.in[24] + (size_t)l * DM * DM, DM, DM, Wb + W_OUT / 2, DM, 0, scr, r, F.lane);
    }
    const float* pw = a.in[20] + (size_t)l * 4 * 128 * 128; const float* ps = a.in[21] + (size_t)l * 512; const float* wc = a.in[22] + (size_t)l * 512 * DM;
    bf16* WcT = Wb + W_C / 2;
    for (int o = F.bid * NTHR + F.tid; o < 512 * DM; o += F.G * NTHR) {
        const int n = o & 1023, k = o >> 10, g = k >> 7;
        const float* pr = pw + (size_t)k * 128; const float* sc = ps + g * 128; const float* wr = wc + (size_t)(g * 128) * DM + n;
        float acc = 0.f;
#pragma unroll 4
        for (int d = 0; d < 128; ++d) acc += pr[d] * sc[d] * wr[(size_t)d * DM];
        WcT[(size_t)n * 512 + k] = (bf16)(pk2(acc, 0.f) & 0xffffu);
    }
}

DI void build_tables(const Ctx& F, const Args& a) {
    const int gt = F.bid * NTHR + F.tid, NT_ = F.G * NTHR;
    float* cosT = (float*)(a.ws + WS_COS); float* sinT = (float*)(a.ws + WS_SIN);
    for (int o = gt; o < SEQ * 16; o += NT_) { const int s = o >> 4, i = o & 15;
        const float inv = __builtin_amdgcn_exp2f(-(float)i * (13.287712379549449f / 16.0f));
        const float ang = (float)s * inv; float sn, cs; sincos_turns((double)ang * 0.15915494309189533577, sn, cs); cosT[o] = cs; sinT[o] = sn; }
    float* tw = (float*)(a.ws + WS_TW);
    for (int o = gt; o < 8192; o += NT_) { float sn, cs; sincos_turns((double)o / 8192.0, sn, cs); tw[2 * o] = cs; tw[2 * o + 1] = sn; }
    bf16* wdc = (bf16*)(a.ws + WS_WDFTC);
    for (int o = gt; o < 256 * 128; o += NT_) { const int m = o >> 7, c = o & 127, ri = m >> 7, kc = m & 127; float sn, cs; sincos_turns((double)((kc * c) & 127) / 128.0, sn, cs);
        const float v = (ri == 0 ? cs : -sn) * 0.08838834764831845f; wdc[o] = (bf16)(pk2(v, 0.f) & 0xffffu); }
    bf16* wfa = (bf16*)(a.ws + WS_WFFTA);
    for (int o = gt; o < 256 * 256; o += NT_) { const int m = o >> 8, k = o & 255, rp = m >> 7, k1 = m & 127, ri = k >> 7, s1 = k & 127; float sn, cs; sincos_turns((double)((k1 * s1) & 127) / 128.0, sn, cs);
        const float v = (rp == ri ? cs : (rp == 0 ? sn : -sn)) * 0.08838834764831845f; wfa[o] = (bf16)(pk2(v, 0.f) & 0xffffu); }
    bf16* w64 = (bf16*)(a.ws + WS_W64);
    for (int o = gt; o < 256 * 128; o += NT_) { const int m = o >> 7, k = o & 127, ri = k >> 6, s2 = k & 63; float sn, cs; sincos_turns((double)((m * s2) & 63) / 64.0, sn, cs);
        const float v = m < 64 ? (ri == 0 ? cs : sn) * 0.125f : 0.f; w64[o] = (bf16)(pk2(v, 0.f) & 0xffffu); }
}

DI void compute_mod(const Ctx& F, const Args& a) {
    LAS float* sc = (LAS float*)F.lds;
    LAS float* part = (LAS float*)(F.lds + 16384);
    const float* c = a.in[1];
    for (int i = F.tid; i < 4 * DM; i += NTHR) { const float v = c[i]; sc[i] = v * sigm(v); }
    __syncthreads();
    float* mod = (float*)(a.ws + WS_MOD);
    for (int it = F.bid; it < DEPTH * 144; it += F.G) {
        const int l = it / 144, j0 = (it % 144) * 64, j = j0 + F.lane;
        const float* w = a.in[2] + (size_t)l * DM * (NMOD * DM) + j;
        float a0 = 0.f, a1 = 0.f, a2 = 0.f, a3 = 0.f;
        const int kb = F.wave * 128;
#pragma unroll 4
        for (int k = 0; k < 128; ++k) { const float wv = w[(size_t)(kb + k) * (NMOD * DM)]; a0 += sc[kb + k] * wv; a1 += sc[1024 + kb + k] * wv; a2 += sc[2048 + kb + k] * wv; a3 += sc[3072 + kb + k] * wv; }
        part[(F.wave * 4 + 0) * 64 + F.lane] = a0; part[(F.wave * 4 + 1) * 64 + F.lane] = a1; part[(F.wave * 4 + 2) * 64 + F.lane] = a2; part[(F.wave * 4 + 3) * 64 + F.lane] = a3;
        __syncthreads();
        if (F.wave < 4) { float s = a.in[3][(size_t)l * NMOD * DM + j];
#pragma unroll
            for (int w8 = 0; w8 < 8; ++w8) s += part[(w8 * 4 + F.wave) * 64 + F.lane];
            mod[((size_t)l * 4 + F.wave) * (NMOD * DM) + j] = s; }
        __syncthreads();
    }
}

DI void rowwise(const Ctx& F0, const float* xin, const bf16* y, float ymul, const float* gate, const float* gy, float* xout,
                const float* gn, const float* shift, const float* scale, bf16* H, bool has_y, bool has_next) {
    Ctx F = F0; asm volatile("" : "+v"(F.tid), "+v"(F.lane));
    const int gw = F.bid * NWAVES + F.wave, NGW = F.G * NWAVES;
    for (int rb = gw; rb < T; rb += 2 * NGW) {
        f32x4 x[2][4]; f32x4 yv[2][4];
#pragma unroll
        for (int u = 0; u < 2; ++u) { const int r = rb + u * NGW; if (r < T) { const size_t ro = (size_t)r * DM;
#pragma unroll
            for (int j = 0; j < 4; ++j) x[u][j] = *(const f32x4*)(xin + ro + 4 * F.lane + 256 * j);
            if (has_y) {
#pragma unroll
                for (int j = 0; j < 4; ++j) { const v2u w = *(const v2u*)(y + ro + 4 * F.lane + 256 * j); yv[u][j] = (f32x4){bflo(w.x), bfhi(w.x), bflo(w.y), bfhi(w.y)}; } } } }
#pragma unroll
        for (int u = 0; u < 2; ++u) { const int r = rb + u * NGW; if (r < T) { const int b = r >> 13; const size_t ro = (size_t)r * DM;
            if (has_y) {
                float ss = 0.f;
#pragma unroll
                for (int j = 0; j < 4; ++j) ss += (yv[u][j][0] * yv[u][j][0] + yv[u][j][1] * yv[u][j][1]) + (yv[u][j][2] * yv[u][j][2] + yv[u][j][3] * yv[u][j][3]);
                const float ry = __builtin_amdgcn_rsqf(wave_sum(ss) * (1.0f / DM) + EPS) * ymul;
#pragma unroll
                for (int j = 0; j < 4; ++j) { const int c = 4 * F.lane + 256 * j; const f32x4 gt = *(const f32x4*)(gate + (size_t)b * (NMOD * DM) + c), gg = *(const f32x4*)(gy + c);
                    x[u][j] += gt * (yv[u][j] * ry * gg); }
            }
#pragma unroll
            for (int j = 0; j < 4; ++j) *(f32x4*)(xout + ro + 4 * F.lane + 256 * j) = x[u][j];
            if (has_next) {
                float ss = 0.f;
#pragma unroll
                for (int j = 0; j < 4; ++j) ss += (x[u][j][0] * x[u][j][0] + x[u][j][1] * x[u][j][1]) + (x[u][j][2] * x[u][j][2] + x[u][j][3] * x[u][j][3]);
                const float rx = __builtin_amdgcn_rsqf(wave_sum(ss) * (1.0f / DM) + EPS);
#pragma unroll
                for (int j = 0; j < 4; ++j) { const int c = 4 * F.lane + 256 * j;
                    const f32x4 gg = *(const f32x4*)(gn + c), sh = *(const f32x4*)(shift + (size_t)b * (NMOD * DM) + c), sc = *(const f32x4*)(scale + (size_t)b * (NMOD * DM) + c);
                    const f32x4 h = (x[u][j] * rx * gg) * (sc + 1.0f) + sh;
                    v2u w; w.x = pk2(h[0], h[1]); w.y = pk2(h[2], h[3]); *(v2u*)(H + ro + c) = w; }
            } } }
    }
}

DI void mixer_pre(const Ctx& F0, const Args& a, int l) {
    Ctx F = F0; asm volatile("" : "+v"(F.tid), "+v"(F.lane));
    const bf16* ZA = (const bf16*)(a.ws + WS_ZA); const bf16* U = (const bf16*)(a.ws + WS_U); const bf16* ZC = (const bf16*)(a.ws + WS_ZC);
    bf16* cqn = (bf16*)(a.ws + WS_CQN); bf16* ckvn = (bf16*)(a.ws + WS_CKVN); bf16* kr = (bf16*)(a.ws + WS_KR);
    bf16* yb = (bf16*)(a.ws + WS_YB); bf16* dp = (bf16*)(a.ws + WS_DP);
    const float* cosT = (const float*)(a.ws + WS_COS); const float* sinT = (const float*)(a.ws + WS_SIN);
    const float* qg = a.in[10] + (size_t)l * QL; const float* kvg = a.in[12] + (size_t)l * KVL;
    const int gw = F.bid * NWAVES + F.wave, NGW = F.G * NWAVES; const int lane = F.lane;
    for (int r = gw; r < T; r += NGW) {
        const int s = r & 8191;
        const v4u w = *(const v4u*)(ZA + (size_t)r * 512 + lane * 8);
        float f[8] = {bflo(w.x), bfhi(w.x), bflo(w.y), bfhi(w.y), bflo(w.z), bfhi(w.z), bflo(w.w), bfhi(w.w)};
        float ss = 0.f;
#pragma unroll
        for (int j = 0; j < 8; ++j) ss += f[j] * f[j];
        const float ssq = wave_sum(lane < 44 ? ss : 0.f), sskv = wave_sum((lane >= 44 && lane < 60) ? ss : 0.f);
        const float rq = __builtin_amdgcn_rsqf(ssq * (1.0f / QL) + EPS), rkv = __builtin_amdgcn_rsqf(sskv * (1.0f / KVL) + EPS);
        float oth[8];
#pragma unroll
        for (int j = 0; j < 8; ++j) oth[j] = __shfl_xor(f[j], 2);
        if (lane < 44) { const f32x4 g0 = *(const f32x4*)(qg + lane * 8), g1 = *(const f32x4*)(qg + lane * 8 + 4);
            v4u o; o.x = pk2(f[0] * rq * g0[0], f[1] * rq * g0[1]); o.y = pk2(f[2] * rq * g0[2], f[3] * rq * g0[3]); o.z = pk2(f[4] * rq * g1[0], f[5] * rq * g1[1]); o.w = pk2(f[6] * rq * g1[2], f[7] * rq * g1[3]);
            *(v4u*)(cqn + (size_t)r * QLP + lane * 8) = o;
        } else if (lane < 60) { const int c0 = (lane - 44) * 8; const f32x4 g0 = *(const f32x4*)(kvg + c0), g1 = *(const f32x4*)(kvg + c0 + 4);
            v4u o; o.x = pk2(f[0] * rkv * g0[0], f[1] * rkv * g0[1]); o.y = pk2(f[2] * rkv * g0[2], f[3] * rkv * g0[3]); o.z = pk2(f[4] * rkv * g1[0], f[5] * rkv * g1[1]); o.w = pk2(f[6] * rkv * g1[2], f[7] * rkv * g1[3]);
            *(v4u*)(ckvn + (size_t)r * KVL + c0) = o;
            if (lane < 48) { const v4u z = {0u, 0u, 0u, 0u}; *(v4u*)(cqn + (size_t)r * QLP + QL + (lane - 44) * 8) = z; }
        } else { const int hi2 = (lane >= 62), i0 = ((lane - 60) & 1) * 8;
            const f32x4 c0 = *(const f32x4*)(cosT + s * 16 + i0), c1 = *(const f32x4*)(cosT + s * 16 + i0 + 4), s0 = *(const f32x4*)(sinT + s * 16 + i0), s1 = *(const f32x4*)(sinT + s * 16 + i0 + 4);
            float o8[8];
#pragma unroll
            for (int j = 0; j < 8; ++j) { const float cc = j < 4 ? c0[j & 3] : c1[j & 3], sn = j < 4 ? s0[j & 3] : s1[j & 3];
                o8[j] = hi2 ? (oth[j] * sn + f[j] * cc) : (f[j] * cc - oth[j] * sn); }
            v4u o; o.x = pk2(o8[0], o8[1]); o.y = pk2(o8[2], o8[3]); o.z = pk2(o8[4], o8[5]); o.w = pk2(o8[6], o8[7]);
            *(v4u*)(kr + (size_t)r * 32 + hi2 * 16 + i0) = o; }
        { const int g = lane >> 4, wlen = 2 << g, lo = wlen >> 1; float sum[8] = {0.f, 0.f, 0.f, 0.f, 0.f, 0.f, 0.f, 0.f}; int cnt = 0;
          const bf16* zb = ZC + (size_t)(r - s) * 512 + lane * 8;
#pragma unroll 4
          for (int k = 0; k < 16; ++k) { const int sr = s - lo + k;
              if (k < wlen && sr >= 0 && sr < SEQ) { const v4u v = *(const v4u*)(zb + (size_t)sr * 512); ++cnt;
                  sum[0] += bflo(v.x); sum[1] += bfhi(v.x); sum[2] += bflo(v.y); sum[3] += bfhi(v.y); sum[4] += bflo(v.z); sum[5] += bfhi(v.z); sum[6] += bflo(v.w); sum[7] += bfhi(v.w); } }
          const v4u v = *(const v4u*)(zb + (size_t)s * 512); const float ic = 1.0f / (float)cnt;
          v4u o; o.x = pk2(sum[0] * ic - bflo(v.x), sum[1] * ic - bfhi(v.x)); o.y = pk2(sum[2] * ic - bflo(v.y), sum[3] * ic - bfhi(v.y));
          o.z = pk2(sum[4] * ic - bflo(v.z), sum[5] * ic - bfhi(v.z)); o.w = pk2(sum[6] * ic - bflo(v.w), sum[7] * ic - bfhi(v.w));
          *(v4u*)(dp + (size_t)r * 512 + lane * 8) = o; }
    }
    LAS float* lu = (LAS float*)F.lds;
    LAS float* ly = (LAS float*)(F.lds + 62 * 256 * 4);
    const float* cw = a.in[15] + (size_t)l * 31 * 256; const float* cb = a.in[16] + (size_t)l * 256;
    const float* lg = a.in[17] + (size_t)l * 256; const float* lb = a.in[18] + (size_t)l * 256;
    const int ch = F.tid & 255, part = F.tid >> 8;
    float wreg[31];
#pragma unroll
    for (int j = 0; j < 31; ++j) wreg[j] = cw[j * 256 + ch];
    const float bias = cb[ch];
    for (int tile = F.bid; tile < T / 32; tile += F.G) {
        const int t0 = tile * 32, s0 = t0 & 8191, tb = t0 - s0;
        for (int c = F.tid; c < 62 * 32; c += NTHR) { const int row = c >> 5, cc = c & 31, sr = s0 - 15 + row;
            v4u v = {0u, 0u, 0u, 0u}; if (sr >= 0 && sr < SEQ) v = *(const v4u*)(U + (size_t)(tb + sr) * 256 + cc * 8);
            LAS float* d = lu + row * 256 + cc * 8;
            *(LAS f32x4*)d = (f32x4){bflo(v.x), bfhi(v.x), bflo(v.y), bfhi(v.y)}; *(LAS f32x4*)(d + 4) = (f32x4){bflo(v.z), bfhi(v.z), bflo(v.w), bfhi(v.w)}; }
        __syncthreads();
#pragma unroll 2
        for (int tk = 0; tk < 16; ++tk) { const int tok = part * 16 + tk; float acc = bias;
#pragma unroll
            for (int j = 0; j < 31; ++j) acc += wreg[j] * lu[(tok + j) * 256 + ch];
            ly[tok * 256 + ch] = acc; }
        __syncthreads();
#pragma unroll
        for (int q = 0; q < 4; ++q) { const int tok = F.wave * 4 + q; const f32x4 v = *(const LAS f32x4*)(ly + tok * 256 + lane * 4);
            const float mean = wave_sum((v[0] + v[1]) + (v[2] + v[3])) * (1.0f / 256.0f); const f32x4 d = v - mean;
            const float var = wave_sum((d[0] * d[0] + d[1] * d[1]) + (d[2] * d[2] + d[3] * d[3])) * (1.0f / 256.0f);
            const float rs = __builtin_amdgcn_rsqf(var + EPS);
            const f32x4 yn = d * rs * *(const f32x4*)(lg + lane * 4) + *(const f32x4*)(lb + lane * 4);
            v2u o; o.x = pk2(yn[0] * sigm(yn[0]), yn[1] * sigm(yn[1])); o.y = pk2(yn[2] * sigm(yn[2]), yn[3] * sigm(yn[3]));
            *(v2u*)(yb + (size_t)(t0 + tok) * 256 + lane * 4) = o; }
        __syncthreads();
    }
}

constexpr int AK_ROW = 208, AV_ROW = 136, AK_BUF = 64 * AK_ROW, AV_BUF = 64 * AV_ROW;
DI void attn_phase(const Ctx& F0, const bf16* Q, const bf16* Kn, const bf16* Kr, const bf16* Vt, bf16* O) {
    Ctx F = F0; asm volatile("" : "+v"(F.tid), "+v"(F.lane));
    const int tid = F.tid, lane = F.lane, wid = F.wave, r = lane & 31, h = lane >> 5;
    LAS unsigned char* lds = F.lds;
    for (int un = F.bid; un < 1024; un += F.G) {
        const int bh = (un & 7) + 8 * (un >> 8), qb = (un >> 3) & 31, b = bh >> 3, hd = bh & 7;
        const bf16* Qp = Q + ((size_t)bh * SEQ + qb * 256 + wid * 32 + r) * 96 + h * 8;
        bf16x8 qr[6];
#pragma unroll
        for (int d0 = 0; d0 < 6; ++d0) qr[d0] = *(const bf16x8*)(Qp + d0 * 16);
        const bf16* kn_src = Kn + ((size_t)bh * SEQ + (tid >> 3)) * 64 + (tid & 7) * 8;
        const bf16* kr_src = Kr + ((size_t)b * SEQ + ((tid & 255) >> 2)) * 32 + (tid & 3) * 8;
        const bf16* v_src = Vt + ((size_t)bh * 64 + (tid >> 3)) * SEQ + (tid & 7) * 8;
        const int kn_dst = (tid >> 3) * AK_ROW + (tid & 7) * 16, kr_dst = ((tid & 255) >> 2) * AK_ROW + 128 + (tid & 3) * 16, v_dst = 2 * AK_BUF + (tid >> 3) * AV_ROW + (tid & 7) * 16;
        v4u g0, g1, g2;
        g0 = *(const v4u*)kn_src; g1 = *(const v4u*)kr_src; g2 = *(const v4u*)v_src;
        *(LAS v4u*)(lds + kn_dst) = g0; if (tid < 256) *(LAS v4u*)(lds + kr_dst) = g1;
        *(LAS v2u*)(lds + v_dst) = (v2u){g2.x, g2.y}; *(LAS v2u*)(lds + v_dst + 8) = (v2u){g2.z, g2.w};
        __syncthreads();
        f32x16 o0, o1, negm;
#pragma unroll
        for (int i = 0; i < 16; ++i) { o0[i] = 0.f; o1[i] = 0.f; negm[i] = 0.f; }
        float lrun = 0.f;
#pragma unroll 1
        for (int t = 0; t < SEQ / 64; ++t) {
            const int cur = t & 1, nxt = cur ^ 1; const bool more = (t + 1 < SEQ / 64);
            if (more) { g0 = *(const v4u*)(kn_src + (size_t)(t + 1) * 64 * 64); g1 = *(const v4u*)(kr_src + (size_t)(t + 1) * 64 * 32); g2 = *(const v4u*)(v_src + (t + 1) * 64); }
            const LAS unsigned char* kb = lds + cur * AK_BUF + r * AK_ROW + h * 16;
            const LAS unsigned char* vb = lds + 2 * AK_BUF + cur * AV_BUF + r * AV_ROW + h * 8;
            f32x16 p0 = negm, p1 = negm;
#pragma unroll
            for (int d0 = 0; d0 < 6; ++d0) { const bf16x8 a0 = *(const LAS bf16x8*)(kb + d0 * 32), a1 = *(const LAS bf16x8*)(kb + 32 * AK_ROW + d0 * 32);
                p0 = __builtin_amdgcn_mfma_f32_32x32x16_bf16(a0, qr[d0], p0, 0, 0, 0); p1 = __builtin_amdgcn_mfma_f32_32x32x16_bf16(a1, qr[d0], p1, 0, 0, 0); }
            float mx = __builtin_fmaxf(__builtin_fmaxf(p0[0], p0[1]), p1[0]);
#pragma unroll
            for (int i = 2; i < 16; i += 2) mx = __builtin_fmaxf(__builtin_fmaxf(mx, p0[i]), p0[i + 1]);
#pragma unroll
            for (int i = 1; i < 15; i += 2) mx = __builtin_fmaxf(__builtin_fmaxf(mx, p1[i]), p1[i + 1]);
            mx = __builtin_fmaxf(mx, p1[15]);
            mx = __builtin_fmaxf(mx, __shfl_xor(mx, 32));
            if (t == 0 || __any(mx > 8.0f)) {
                const float dl = (t == 0) ? mx : __builtin_fmaxf(mx, 0.f), f = (t == 0) ? 1.0f : __builtin_amdgcn_exp2f(-dl);
#pragma unroll
                for (int i = 0; i < 16; ++i) { p0[i] -= dl; p1[i] -= dl; negm[i] -= dl; o0[i] *= f; o1[i] *= f; }
                lrun *= f;
            }
            float ps0 = 0.f, ps1 = 0.f;
#pragma unroll
            for (int i = 0; i < 16; ++i) { p0[i] = __builtin_amdgcn_exp2f(p0[i]); p1[i] = __builtin_amdgcn_exp2f(p1[i]); ps0 += p0[i]; ps1 += p1[i]; }
            lrun += ps0 + ps1;
#pragma unroll
            for (int st = 0; st < 4; ++st) {
                v4u pw;
                if (st == 0) { pw.x = pk2(p0[0], p0[1]); pw.y = pk2(p0[2], p0[3]); pw.z = pk2(p0[4], p0[5]); pw.w = pk2(p0[6], p0[7]); }
                else if (st == 1) { pw.x = pk2(p0[8], p0[9]); pw.y = pk2(p0[10], p0[11]); pw.z = pk2(p0[12], p0[13]); pw.w = pk2(p0[14], p0[15]); }
                else if (st == 2) { pw.x = pk2(p1[0], p1[1]); pw.y = pk2(p1[2], p1[3]); pw.z = pk2(p1[4], p1[5]); pw.w = pk2(p1[6], p1[7]); }
                else { pw.x = pk2(p1[8], p1[9]); pw.y = pk2(p1[10], p1[11]); pw.z = pk2(p1[12], p1[13]); pw.w = pk2(p1[14], p1[15]); }
                const bf16x8 pb = __builtin_bit_cast(bf16x8, pw);
                const v2u va0 = *(const LAS v2u*)(vb + st * 32), va1 = *(const LAS v2u*)(vb + st * 32 + 16);
                const v2u vc0 = *(const LAS v2u*)(vb + 32 * AV_ROW + st * 32), vc1 = *(const LAS v2u*)(vb + 32 * AV_ROW + st * 32 + 16);
                const bf16x8 fa = __builtin_bit_cast(bf16x8, (v4u){va0.x, va0.y, va1.x, va1.y}), fc = __builtin_bit_cast(bf16x8, (v4u){vc0.x, vc0.y, vc1.x, vc1.y});
                o0 = __builtin_amdgcn_mfma_f32_32x32x16_bf16(fa, pb, o0, 0, 0, 0); o1 = __builtin_amdgcn_mfma_f32_32x32x16_bf16(fc, pb, o1, 0, 0, 0);
            }
            if (more) { *(LAS v4u*)(lds + nxt * AK_BUF + kn_dst) = g0; if (tid < 256) *(LAS v4u*)(lds + nxt * AK_BUF + kr_dst) = g1;
                *(LAS v2u*)(lds + nxt * AV_BUF + v_dst) = (v2u){g2.x, g2.y}; *(LAS v2u*)(lds + nxt * AV_BUF + v_dst + 8) = (v2u){g2.z, g2.w}; }
            __syncthreads();
        }
        const float ltot = lrun + __shfl_xor(lrun, 32), inv = 1.0f / ltot;
        bf16* Op = O + ((size_t)b * SEQ + qb * 256 + wid * 32 + r) * 512 + hd * 64 + 4 * h;
#pragma unroll
        for (int g = 0; g < 4; ++g) {
            v2u w0, w1; w0.x = pk2(o0[4 * g] * inv, o0[4 * g + 1] * inv); w0.y = pk2(o0[4 * g + 2] * inv, o0[4 * g + 3] * inv);
            w1.x = pk2(o1[4 * g] * inv, o1[4 * g + 1] * inv); w1.y = pk2(o1[4 * g + 2] * inv, o1[4 * g + 3] * inv);
            *(v2u*)(Op + 8 * g) = w0; *(v2u*)(Op + 32 + 8 * g) = w1; }
    }
}

template <class Epi> DI void run_gemm(const Ctx& F, const bf16* A, const bf16* Bt, int M, int N, int K, const Epi& E) {
    int Kv = K; asm volatile("" : "+s"(Kv)); pg8::Gemm g{A, Bt, M, N, Kv}; pg8::StaticOrder S; S.init(M, N, F.G, F.bid);
    pg8::gemm_phase<Epi, pg8::StaticOrder, true, true>((PG8_LAS unsigned char*)F.lds, g, S, E);
}

#if defined(__HIP_DEVICE_COMPILE__)
typedef const __attribute__((address_space(4))) Args* ArgsP;
DI Args load_args(ArgsP p) { asm volatile("" : "+s"(p)); Args r; const __attribute__((address_space(4))) unsigned long long* q = (const __attribute__((address_space(4))) unsigned long long*)p; unsigned long long* d = (unsigned long long*)&r;
#pragma unroll
    for (int i = 0; i < (int)(sizeof(Args) / 8); ++i) d[i] = q[i];
    return r; }
#define KERNARG_PTR() ((ArgsP)__builtin_amdgcn_kernarg_segment_ptr())
#else
typedef const Args* ArgsP;
__host__ __device__ static inline Args load_args(ArgsP p) { return *p; }
#define KERNARG_PTR() ((ArgsP)nullptr)
#endif
#define LOADARGS() const Args a = load_args(ap0); unsigned char* const ws = a.ws; bf16* const Wb = (bf16*)(ws + WS_W); bf16* const H = (bf16*)(ws + WS_H); bf16* const ACT = (bf16*)(ws + WS_ACT); bf16* const Y = (bf16*)(ws + WS_Y); float* const X = a.out; \
    const float* const mod = (const float*)(ws + WS_MOD); const float* const ng = a.in[4] + (size_t)l * 6 * DM; const float* const modl = mod + (size_t)l * 4 * NMOD * DM; (void)Wb; (void)H; (void)ACT; (void)Y; (void)X; (void)ng; (void)modl;

#define GSYNC() do { asm volatile("s_waitcnt vmcnt(0) lgkmcnt(0)" ::: "memory"); grid.sync(); __builtin_amdgcn_fence(__ATOMIC_ACQUIRE, "agent"); asm volatile("s_waitcnt vmcnt(0)" ::: "memory"); } while (0)
__global__ void __launch_bounds__(NTHR, 2) fwd_megakernel(Args a_unused) {
    extern __shared__ __attribute__((aligned(16))) unsigned char lds_raw[];
    cg::grid_group grid = cg::this_grid();
    Ctx F; F.tid = threadIdx.x; F.lane = F.tid & 63; F.wave = __builtin_amdgcn_readfirstlane(F.tid >> 6); F.G = gridDim.x; F.bid = blockIdx.x; F.lds = (LAS unsigned char*)lds_raw;
    const ArgsP ap0 = KERNARG_PTR();

    { const int l = 0; LOADARGS();
      build_tables(F, a);
      compute_mod(F, a);
      convert_weights(F, a, 0); }
    GSYNC();
    { const int l = 0; LOADARGS();
      rowwise(F, a.in[0], nullptr, 0.f, nullptr, nullptr, X, a.in[4], mod + 0 * DM, mod + 1 * DM, H, false, true); }
    GSYNC();

#pragma unroll 1
    for (int l = 0; l < DEPTH; ++l) {
#pragma unroll 1
        for (int half = 0; half < 2; ++half) {
            { LOADARGS(); pg8::EpiSwiglu E{ACT, DFF}; run_gemm(F, H, Wb + (half * W_FFN_STRIDE + W_FFN_IN) / 2, T, 2 * DFF, DM, E); }
            GSYNC();
            { LOADARGS(); pg8::EpiPlain E{Y, DM}; run_gemm(F, ACT, Wb + (half * W_FFN_STRIDE + W_FFN_OUT) / 2, T, DM, DFF, E); }
            GSYNC();
            { LOADARGS();
              if (half == 0) rowwise(F, X, Y, 0.5f, modl + 2 * DM, ng + 1 * DM, X, ng + 2 * DM, modl + 3 * DM, modl + 4 * DM, H, true, true);
              else {
                const bool nxt = (l + 1 < DEPTH);
                rowwise(F, X, Y, 0.5f, modl + 8 * DM, ng + 5 * DM, X, ng + 6 * DM, modl + 4 * NMOD * DM, modl + 4 * NMOD * DM + DM, H, true, nxt);
                if (nxt) convert_weights(F, a, l + 1);
              } }
            GSYNC();
            if (half == 0) {
                { LOADARGS(); pg8::EpiMixA E{(bf16*)(ws + WS_ZA), (bf16*)(ws + WS_U), (bf16*)(ws + WS_ZC), (bf16*)(ws + WS_ZD)}; run_gemm(F, H, Wb + W_MIXIN / 2, T, 2048, DM, E); }
                GSYNC();
                { LOADARGS(); mixer_pre(F, a, l); }
                GSYNC();
                { LOADARGS(); pg8::EpiDftC E{(bf16*)(ws + WS_ZT)}; run_gemm(F, (const bf16*)(ws + WS_WDFTC), (const bf16*)(ws + WS_ZD), 256, T * 4, 128, E); }
                { LOADARGS(); pg8::EpiQ E{(bf16*)(ws + WS_Q), (const float*)(ws + WS_COS), (const float*)(ws + WS_SIN), C2}; run_gemm(F, (const bf16*)(ws + WS_CQN), Wb + W_UQ / 2, T, 768, QLP, E); }
                { LOADARGS(); pg8::EpiK E{(bf16*)(ws + WS_KN)}; run_gemm(F, (const bf16*)(ws + WS_CKVN), Wb + W_UKV / 2, T, 512, KVL, E); }
                { LOADARGS(); pg8::EpiVt E{(bf16*)(ws + WS_VT)}; run_gemm(F, Wb + W_UKV / 2 + 512 * KVL, (const bf16*)(ws + WS_CKVN), 512, T, KVL, E); }
                GSYNC();
                { LOADARGS(); pg8::EpiFftA E{(bf16*)(ws + WS_YP), (const pg8::f32x2_t*)(ws + WS_TW)}; run_gemm(F, (const bf16*)(ws + WS_WFFTA), (const bf16*)(ws + WS_ZT), 256, T * 4, 256, E); }
                { LOADARGS(); attn_phase(F, (const bf16*)(ws + WS_Q), (const bf16*)(ws + WS_KN), (const bf16*)(ws + WS_KR), (const bf16*)(ws + WS_VT), (bf16*)(ws + WS_O)); }
                GSYNC();
                { LOADARGS(); pg8::EpiFftC E{(bf16*)(ws + WS_F)}; run_gemm(F, (const bf16*)(ws + WS_W64), (const bf16*)(ws + WS_YP), 256, T * 8, 128, E); }
                GSYNC();
                { LOADARGS(); pg8::EpiSigm E{(bf16*)(ws + WS_GATES), 4096}; run_gemm(F, H, Wb + W_MIXIN / 2 + (size_t)2048 * DM, T, 4096, DM, E); }
                GSYNC();
#pragma unroll 1
                for (int br = 0; br < 4; ++br) { LOADARGS();
                    const bf16* A = br == 0 ? (const bf16*)(ws + WS_O) : br == 1 ? (const bf16*)(ws + WS_YB) : br == 2 ? (const bf16*)(ws + WS_DP) : (const bf16*)(ws + WS_F);
                    const bf16* B = br == 0 ? Wb + W_A / 2 : br == 1 ? Wb + W_B / 2 : br == 2 ? Wb + W_C / 2 : Wb + W_D / 2;
                    pg8::EpiMerge E{H, (const bf16*)(ws + WS_GATES), br}; run_gemm(F, A, B, T, DM, br == 1 ? 256 : 512, E);
                }
                GSYNC();
                { LOADARGS(); pg8::EpiPlain E{Y, DM}; run_gemm(F, H, Wb + W_OUT / 2, T, DM, DM, E); }
                GSYNC();
                { LOADARGS(); rowwise(F, X, Y, 1.0f, modl + 5 * DM, ng + 3 * DM, X, ng + 4 * DM, modl + 6 * DM, modl + 7 * DM, H, true, true); }
                GSYNC();
            }
        }
    }
}

extern "C" void kernel_launch(void* const* d_in, const int* in_sizes, int n_in, void* d_out, int out_size, void* d_ws, size_t ws_size, hipStream_t stream) {
    static int grid = 0;
    if (grid == 0) {
        int dev = 0, cus = 0, per_cu = 0;
        hipGetDevice(&dev); hipDeviceGetAttribute(&cus, hipDeviceAttributeMultiprocessorCount, dev);
        hipFuncSetAttribute((const void*)fwd_megakernel, hipFuncAttributeMaxDynamicSharedMemorySize, LDS_BYTES);
        hipOccupancyMaxActiveBlocksPerMultiprocessor(&per_cu, (const void*)fwd_megakernel, NTHR, LDS_BYTES);
        (void)hipGetLastError();
        if (n_in != 25 || ws_size < WS_END || per_cu < 1) { fprintf(stderr, "kernel_launch: unexpected config n_in %d ws %zu per_cu %d\n", n_in, ws_size, per_cu); if (per_cu < 1) per_cu = 1; }
        grid = cus > 0 ? cus : 256;
    }
    Args a{};
    for (int i = 0; i < 25; ++i) a.in[i] = (const float*)d_in[i];
    a.out = (float*)d_out; a.ws = (unsigned char*)d_ws;
    void* args[] = {&a};
    hipError_t e = hipLaunchCooperativeKernel((const void*)fwd_megakernel, dim3(grid), dim3(NTHR), args, LDS_BYTES, stream);
    if (e != hipSuccess) fprintf(stderr, "cooperative launch failed: %s (grid %d)\n", hipGetErrorString(e), grid);
}
```

```cpp
#include <hip/hip_runtime.h>
#include <hip/hip_cooperative_groups.h>
#include <cstdio>
#include <cstdint>
namespace cg = cooperative_groups;
#ifndef DBG_MASK
#define DBG_MASK 0
#endif
namespace pg8 {
#define PG8_LAS __attribute__((address_space(3)))
typedef unsigned short bf16_t;
typedef short bf16x8 __attribute__((ext_vector_type(8)));
typedef float f32x4 __attribute__((ext_vector_type(4)));
typedef unsigned u32x4 __attribute__((ext_vector_type(4)));
constexpr int BM = 256, BK = 64, HALF = 128, HTB = HALF * BK * 2  , STAGE_BYTES = 8 * HTB, NXCD = 8, WGM = 8;

__host__ __device__ __forceinline__ int lds_byte(int r, int c) { const int st = (r >> 4) * 2 + (c >> 5), rr = r & 15, cc = c & 31, ob = rr * 64 + cc * 2; return st * 1024 + (ob ^ (((ob >> 9) & 1) << 5)); }
__host__ __device__ __forceinline__ void stage_rc(int b, int& R, int& C) { const int st = b / 1024, sb = b % 1024, swz = sb ^ (((sb >> 9) & 1) << 5); R = (st >> 1) * 16 + swz / 64; C = (st & 1) * 32 + (swz % 64) / 2; }
__host__ __device__ __forceinline__ int perm32(int rho) { const int n = rho >> 4, i = rho & 15; return 8 * (i >> 2) + 4 * n + (i & 3); }

struct Unit { int pm, pn; };
struct Gemm { const bf16_t* A; const bf16_t* Bt; int M, N, K; };

struct StaticOrder {
    int nM, nN, nwg, G, c;
    __host__ __device__ void init(int M, int N, int G_, int c_) { nM = M / BM; nN = N / BM; nwg = nM * nN; G = G_; c = c_; }
    __host__ __device__ bool next(int i, Unit& u) const {
        const long L = (long)i * G + c; if (L >= nwg) return false;
        int wgid = (int)L; { const int q = nwg / NXCD, r = nwg % NXCD, xcd = wgid % NXCD, off = wgid / NXCD; wgid = (xcd < r ? xcd * (q + 1) : r * (q + 1) + (xcd - r) * q) + off; }
        const int nig = WGM * nN, gid = wgid / nig, fm = gid * WGM, gsz = (nM - fm) < WGM ? (nM - fm) : WGM;
        u.pm = fm + ((wgid % nig) % gsz); u.pn = (wgid % nig) / gsz; return true;
    }
    __device__ __forceinline__ void a_ready(const Unit&) const {}
    __device__ __forceinline__ void done(const Unit&) const {}
};

typedef float f32x2_t __attribute__((ext_vector_type(2))); typedef __bf16 bf16x2_t __attribute__((ext_vector_type(2)));
typedef unsigned u32x2 __attribute__((ext_vector_type(2)));
__device__ __forceinline__ unsigned pk2(float lo, float hi) { f32x2_t v = {lo, hi}; bf16x2_t b = __builtin_convertvector(v, bf16x2_t); return __builtin_bit_cast(unsigned, b); }
__device__ __forceinline__ u32x4 pack8(f32x4 a, f32x4 b) { u32x4 w; w.x = pk2(a[0], a[1]); w.y = pk2(a[2], a[3]); w.z = pk2(b[0], b[1]); w.w = pk2(b[2], b[3]); return w; }
__device__ __forceinline__ u32x2 pack4(f32x4 a) { u32x2 w; w.x = pk2(a[0], a[1]); w.y = pk2(a[2], a[3]); return w; }
__device__ __forceinline__ float bflo(unsigned u) { return __uint_as_float(u << 16); }
__device__ __forceinline__ float bfhi(unsigned u) { return __uint_as_float(u & 0xffff0000u); }
__device__ __forceinline__ float sigm(float x) { return __builtin_amdgcn_rcpf(1.0f + __expf(-x)); }
__device__ __forceinline__ f32x4 sigm4(f32x4 v) { f32x4 o; o[0] = sigm(v[0]); o[1] = sigm(v[1]); o[2] = sigm(v[2]); o[3] = sigm(v[3]); return o; }

struct EpiPlain {
    static constexpr bool PERM = true, AFTER_DRAIN = false;
    bf16_t* O; int ldc;
    __device__ __forceinline__ void operator()(const f32x4 (&acc)[2][2][4][2], const Unit& u, int wr, int wc, int fr, int fq) const {
        const int row0 = u.pm * BM + wr * 64 + fr, col0 = u.pn * BM + wc * 32 + 8 * fq;
#pragma unroll
        for (int ai = 0; ai < 2; ++ai)
#pragma unroll
            for (int m = 0; m < 4; ++m) { asm volatile("" ::: "memory"); bf16_t* rowp = O + (size_t)(row0 + ai * HALF + m * 16) * ldc + col0;
#pragma unroll
                for (int bj = 0; bj < 2; ++bj) *(u32x4*)(rowp + bj * HALF) = pack8(acc[ai][bj][m][0], acc[ai][bj][m][1]); }
    }
};
struct EpiSigm {
    static constexpr bool PERM = true, AFTER_DRAIN = false;
    bf16_t* O; int ldc;
    __device__ __forceinline__ void operator()(const f32x4 (&acc)[2][2][4][2], const Unit& u, int wr, int wc, int fr, int fq) const {
        const int row0 = u.pm * BM + wr * 64 + fr, col0 = u.pn * BM + wc * 32 + 8 * fq;
#pragma unroll
        for (int ai = 0; ai < 2; ++ai)
#pragma unroll
            for (int m = 0; m < 4; ++m) { asm volatile("" ::: "memory"); bf16_t* rowp = O + (size_t)(row0 + ai * HALF + m * 16) * ldc + col0;
#pragma unroll
                for (int bj = 0; bj < 2; ++bj) *(u32x4*)(rowp + bj * HALF) = pack8(sigm4(acc[ai][bj][m][0]), sigm4(acc[ai][bj][m][1])); }
    }
};
struct EpiSwiglu {
    static constexpr bool PERM = true, AFTER_DRAIN = false;
    bf16_t* O; int ldc;
    __device__ __forceinline__ void operator()(const f32x4 (&acc)[2][2][4][2], const Unit& u, int wr, int wc, int fr, int fq) const {
        const int row0 = u.pm * BM + wr * 64 + fr, col0 = u.pn * HALF + wc * 32 + 8 * fq;
#pragma unroll
        for (int ai = 0; ai < 2; ++ai)
#pragma unroll
            for (int m = 0; m < 4; ++m) { asm volatile("" ::: "memory"); bf16_t* rowp = O + (size_t)(row0 + ai * HALF + m * 16) * ldc + col0;
                const f32x4 g0 = acc[ai][0][m][0], g1 = acc[ai][0][m][1], u0 = acc[ai][1][m][0], u1 = acc[ai][1][m][1];
                *(u32x4*)rowp = pack8(g0 * sigm4(g0) * u0, g1 * sigm4(g1) * u1); }
    }
};
struct EpiMixA {
    static constexpr bool PERM = true, AFTER_DRAIN = false;
    bf16_t *ZA, *U, *ZC, *ZD;
    __device__ __forceinline__ void operator()(const f32x4 (&acc)[2][2][4][2], const Unit& u, int wr, int wc, int fr, int fq) const {
        const int row0 = u.pm * BM + wr * 64 + fr, cw = wc * 32 + 8 * fq; const int pn = u.pn;
#pragma unroll
        for (int ai = 0; ai < 2; ++ai)
#pragma unroll
            for (int m = 0; m < 4; ++m) { asm volatile("" ::: "memory"); const int row = row0 + ai * HALF + m * 16;
                if (pn < 2) { bf16_t* p = ZA + (size_t)row * 512 + pn * 256 + cw;
                    *(u32x4*)p = pack8(acc[ai][0][m][0], acc[ai][0][m][1]); *(u32x4*)(p + HALF) = pack8(acc[ai][1][m][0], acc[ai][1][m][1]); }
                else if (pn < 4) { bf16_t* p = U + (size_t)row * 256 + (pn - 2) * HALF + cw;
                    *(u32x4*)p = pack8(acc[ai][0][m][0] * sigm4(acc[ai][1][m][0]), acc[ai][0][m][1] * sigm4(acc[ai][1][m][1])); }
                else if (pn < 6) { bf16_t* p = ZC + (size_t)row * 512 + (pn - 4) * 256 + cw;
                    *(u32x4*)p = pack8(acc[ai][0][m][0], acc[ai][0][m][1]); *(u32x4*)(p + HALF) = pack8(acc[ai][1][m][0], acc[ai][1][m][1]); }
                else { const int b = row >> 13, s = row & 8191, s1 = s >> 6, s2 = s & 63;
#pragma unroll
                    for (int bj = 0; bj < 2; ++bj) { const int cz = (pn - 6) * 256 + bj * HALF + cw, g = cz >> 7, c = cz & 127;
                        bf16_t* p = ZD + ((size_t)(((b * 64 + s2) * 4 + g) * 128 + s1)) * 128 + c;
                        *(u32x4*)p = pack8(acc[ai][bj][m][0], acc[ai][bj][m][1]); } }
            }
    }
};
struct EpiQ {
    static constexpr bool PERM = false, AFTER_DRAIN = false;
    bf16_t* Q; const float* cosT; const float* sinT; float c2;
    __device__ __forceinline__ void operator()(const f32x4 (&acc)[2][2][4][2], const Unit& u, int wr, int wc, int fr, int fq) const {
        const int row0 = u.pm * BM + wr * 64 + fr;
#pragma unroll
        for (int bj = 0; bj < 2; ++bj) { const int g32 = u.pn * 8 + bj * 4 + wc, head = g32 / 3, part = g32 - head * 3;
#pragma unroll
            for (int ai = 0; ai < 2; ++ai)
#pragma unroll
                for (int m = 0; m < 4; ++m) { asm volatile("" ::: "memory"); const int row = row0 + ai * HALF + m * 16, b = row >> 13, s = row & 8191;
                    bf16_t* p = Q + ((size_t)((b * 8 + head) * 8192 + s)) * 96 + part * 32 + 4 * fq;
                    f32x4 x1 = acc[ai][bj][m][0], x2 = acc[ai][bj][m][1];
                    if (part == 2) { const f32x4 c = *(const f32x4*)(cosT + s * 16 + 4 * fq), sn = *(const f32x4*)(sinT + s * 16 + 4 * fq);
                        const f32x4 o1 = x1 * c - x2 * sn, o2 = x1 * sn + x2 * c; x1 = o1; x2 = o2; }
                    *(u32x2*)p = pack4(x1 * c2); *(u32x2*)(p + 16) = pack4(x2 * c2); }
        }
    }
};
struct EpiK {
    static constexpr bool PERM = true, AFTER_DRAIN = false;
    bf16_t* Kn;
    __device__ __forceinline__ void operator()(const f32x4 (&acc)[2][2][4][2], const Unit& u, int wr, int wc, int fr, int fq) const {
        const int row0 = u.pm * BM + wr * 64 + fr;
#pragma unroll
        for (int bj = 0; bj < 2; ++bj) { const int col = u.pn * BM + bj * HALF + wc * 32 + 8 * fq, hd = col >> 6, c = col & 63;
#pragma unroll
            for (int ai = 0; ai < 2; ++ai)
#pragma unroll
                for (int m = 0; m < 4; ++m) { asm volatile("" ::: "memory"); const int row = row0 + ai * HALF + m * 16, b = row >> 13, s = row & 8191;
                    *(u32x4*)(Kn + ((size_t)((b * 8 + hd) * 8192 + s)) * 64 + c) = pack8(acc[ai][bj][m][0], acc[ai][bj][m][1]); }
        }
    }
};
struct EpiVt {
    static constexpr bool PERM = true, AFTER_DRAIN = false;
    bf16_t* Vt;
    __device__ __forceinline__ void operator()(const f32x4 (&acc)[2][2][4][2], const Unit& u, int wr, int wc, int fr, int fq) const {
        const int row0 = u.pm * BM + wr * 64 + fr;
#pragma unroll
        for (int bj = 0; bj < 2; ++bj) { const int t0 = u.pn * BM + bj * HALF + wc * 32 + 8 * fq, b = t0 >> 13, s = t0 & 8191;
#pragma unroll
            for (int ai = 0; ai < 2; ++ai)
#pragma unroll
                for (int m = 0; m < 4; ++m) { asm volatile("" ::: "memory"); const int row = row0 + ai * HALF + m * 16;
                    *(u32x4*)(Vt + ((size_t)(b * 512 + row)) * 8192 + s) = pack8(acc[ai][bj][m][0], acc[ai][bj][m][1]); }
        }
    }
};
struct EpiDftC {
    static constexpr bool PERM = true, AFTER_DRAIN = false;
    bf16_t* Zt;
    __device__ __forceinline__ void operator()(const f32x4 (&acc)[2][2][4][2], const Unit& u, int wr, int wc, int fr, int fq) const {
#pragma unroll
        for (int bj = 0; bj < 2; ++bj) { const int n = u.pn * BM + bj * HALF + wc * 32 + 8 * fq, s1 = n & 127, g = (n >> 7) & 3, s2 = (n >> 9) & 63, b = n >> 15;
#pragma unroll
            for (int ai = 0; ai < 2; ++ai)
#pragma unroll
                for (int m = 0; m < 4; ++m) { asm volatile("" ::: "memory"); const int kc = wr * 64 + m * 16 + fr;
                    *(u32x4*)(Zt + ((size_t)(((b * 4 + g) * 128 + kc) * 64 + s2)) * 256 + ai * 128 + s1) = pack8(acc[ai][bj][m][0], acc[ai][bj][m][1]); }
        }
    }
};
struct EpiFftA {
    static constexpr bool PERM = true, AFTER_DRAIN = false;
    bf16_t* Yp; const f32x2_t* tw;
    __device__ __forceinline__ void operator()(const f32x4 (&acc)[2][2][4][2], const Unit& u, int wr, int wc, int fr, int fq) const {
#pragma unroll
        for (int bj = 0; bj < 2; ++bj) { const int n = u.pn * BM + bj * HALF + wc * 32 + 8 * fq, s2 = n & 63, rest = n >> 6, kc = rest & 127, bg = rest >> 7, b = bg >> 2, g = bg & 3;
#pragma unroll
            for (int m = 0; m < 4; ++m) { asm volatile("" ::: "memory"); int k1 = wr * 64 + m * 16 + fr; asm volatile("" : "+v"(k1));
                bf16_t* p = Yp + ((size_t)(((b * 128 + k1) * 4 + g) * 128 + kc)) * 128 + s2;
#pragma unroll
                for (int hv = 0; hv < 2; ++hv) { f32x4 rr, ii;
#pragma unroll
                    for (int e = 0; e < 4; ++e) { const f32x2_t t0 = tw[k1 * (s2 + 4 * hv + e)]; const float yr = acc[0][bj][m][hv][e], yi = acc[1][bj][m][hv][e];
                        rr[e] = yr * t0.x + yi * t0.y; ii[e] = yi * t0.x - yr * t0.y; }
                    *(u32x2*)(p + 4 * hv) = pack4(rr); *(u32x2*)(p + 64 + 4 * hv) = pack4(ii); asm volatile("" ::: "memory"); }
            }
        }
    }
};
struct EpiFftC {
    static constexpr bool PERM = true, AFTER_DRAIN = false;
    bf16_t* F;
    __device__ __forceinline__ void operator()(const f32x4 (&acc)[2][2][4][2], const Unit& u, int wr, int wc, int fr, int fq) const {
        if (wr != 0) return;
#pragma unroll
        for (int bj = 0; bj < 2; ++bj) { const int n = u.pn * BM + bj * HALF + wc * 32 + 8 * fq, kc = n & 127, g = (n >> 7) & 3, k1 = (n >> 9) & 127, b = n >> 16;
#pragma unroll
            for (int m = 0; m < 4; ++m) { asm volatile("" ::: "memory"); const int k2 = m * 16 + fr;
                *(u32x4*)(F + ((size_t)(b * 8192 + k1 + 128 * k2)) * 512 + g * 128 + kc) = pack8(acc[0][bj][m][0], acc[0][bj][m][1]); }
        }
    }
};
struct EpiMerge {
    static constexpr bool PERM = true, AFTER_DRAIN = false;
    bf16_t* Mg; const bf16_t* G; int br;
    __device__ __forceinline__ void operator()(const f32x4 (&acc)[2][2][4][2], const Unit& u, int wr, int wc, int fr, int fq) const {
        const int row0 = u.pm * BM + wr * 64 + fr, col0 = u.pn * BM + wc * 32 + 8 * fq;
#pragma unroll
        for (int ai = 0; ai < 2; ++ai)
#pragma unroll
            for (int m = 0; m < 4; ++m) { asm volatile("" ::: "memory"); const int row = row0 + ai * HALF + m * 16;
#pragma unroll
                for (int bj = 0; bj < 2; ++bj) { const int col = col0 + bj * HALF;
                    const u32x4 gw = *(const u32x4*)(G + (size_t)row * 4096 + br * 1024 + col);
                    f32x4 v0 = acc[ai][bj][m][0], v1 = acc[ai][bj][m][1];
                    if ((DBG_MASK >> br) & 1) { v0 = v0 * 0.f; v1 = v1 * 0.f; }
                    v0[0] *= bflo(gw.x); v0[1] *= bfhi(gw.x); v0[2] *= bflo(gw.y); v0[3] *= bfhi(gw.y); v1[0] *= bflo(gw.z); v1[1] *= bfhi(gw.z); v1[2] *= bflo(gw.w); v1[3] *= bfhi(gw.w);
                    bf16_t* p = Mg + (size_t)row * 1024 + col;
                    if (br > 0) { const u32x4 o = *(const u32x4*)p;
                        v0[0] += bflo(o.x); v0[1] += bfhi(o.x); v0[2] += bflo(o.y); v0[3] += bfhi(o.y); v1[0] += bflo(o.z); v1[1] += bfhi(o.z); v1[2] += bflo(o.w); v1[3] += bfhi(o.w); }
                    *(u32x4*)p = pack8(v0, v1); }
            }
    }
};

template <class Epi, class Sched, bool ALIGN_EPI = false, bool SP2 = false>
__device__ __forceinline__ void gemm_phase(PG8_LAS unsigned char* lds, const Gemm g, const Sched& S, const Epi& E) {
    int tid_ = threadIdx.x; asm volatile("" : "+v"(tid_)); const int tid = tid_, wid = __builtin_amdgcn_readfirstlane(tid >> 6), lane = tid & 63, wr = wid >> 2, wc = wid & 3, fr = lane & 15, fq = lane >> 4;
    const int K = g.K, nt = K / BK;
    unsigned voffA[2], voffB[2];
#pragma unroll
    for (int i = 0; i < 2; ++i) { int R, C; stage_rc(tid * 16 + i * 8192, R, C); const int Rb = Epi::PERM ? ((R & ~31) + perm32(R & 31)) : R;
        voffA[i] = (unsigned)(R * K + C) * 2u; voffB[i] = (unsigned)(Rb * K + C) * 2u; }
    const size_t kstep = (size_t)(BK * 2);
    const size_t hstep = (size_t)HALF * K * 2;
    const size_t tstep = 2 * hstep;
    const unsigned ldsw = (unsigned)wid * 1024u;
    const int aoff = lds_byte(wr * 64 + fr, fq * 8), boff = lds_byte(wc * 32 + fr, fq * 8);
#define PG8_SA(b, h) (((b) * 2 + (h)) * HTB)
#define PG8_SB(b, h) ((4 + (b) * 2 + (h)) * HTB)
#define PG8_STAGE(bufoff, gbase, voff) do { _Pragma("unroll") for (int _i = 0; _i < 2; ++_i) \
        __builtin_amdgcn_global_load_lds((const unsigned*)((const char*)(gbase) + (voff)[_i]), (PG8_LAS unsigned*)(lds + (bufoff) + ldsw + _i * 8192), 16, 0, 0); } while (0)
#define PG8_LDA(dst, b, h) do { _Pragma("unroll") for (int m = 0; m < 4; ++m) _Pragma("unroll") for (int k = 0; k < 2; ++k) dst[m][k] = *(const PG8_LAS bf16x8*)(lds + PG8_SA(b, h) + aoff + m * 2048 + k * 1024); } while (0)
#define PG8_LDB(dst, b, h) do { _Pragma("unroll") for (int n = 0; n < 2; ++n) _Pragma("unroll") for (int k = 0; k < 2; ++k) dst[n][k] = *(const PG8_LAS bf16x8*)(lds + PG8_SB(b, h) + boff + n * 2048 + k * 1024); } while (0)
#define PG8_MMA(ai, bj, At, Bt) do { __builtin_amdgcn_s_setprio(1); _Pragma("unroll") for (int m = 0; m < 4; ++m) _Pragma("unroll") for (int n = 0; n < 2; ++n) _Pragma("unroll") for (int k = 0; k < 2; ++k) \
        acc[ai][bj][m][n] = __builtin_amdgcn_mfma_f32_16x16x32_bf16(Bt[n][k], At[m][k], acc[ai][bj][m][n], 0, 0, 0); __builtin_amdgcn_s_setprio(0); } while (0)
#define PG8_WAIT_V(n) asm volatile("s_waitcnt vmcnt(" #n ")" ::: "memory")
#define PG8_WAIT_L(n) asm volatile("s_waitcnt lgkmcnt(" #n ")" ::: "memory")
#define PG8_BAR __builtin_amdgcn_s_barrier()
#define PG8_SCHED __builtin_amdgcn_sched_barrier(0)
    Unit cur, nxt; int ui = 0;
    if (!S.next(0, cur)) return;
    f32x4 acc[2][2][4][2];
#pragma unroll
    for (int a = 0; a < 2; ++a)
#pragma unroll
        for (int b = 0; b < 2; ++b)
#pragma unroll
            for (int m = 0; m < 4; ++m)
#pragma unroll
                for (int n = 0; n < 2; ++n) acc[a][b][m][n] = (f32x4){0.f, 0.f, 0.f, 0.f};
    bf16x8 At[4][2], B0[2][2], B1[2][2];
    const char* cA = (const char*)g.A + (size_t)cur.pm * tstep; const char* cB = (const char*)g.Bt + (size_t)cur.pn * tstep;
    S.a_ready(cur);
    if constexpr (SP2) {
        PG8_STAGE(PG8_SB(0, 0), cB, voffB); PG8_STAGE(PG8_SB(0, 1), cB + hstep, voffB); PG8_STAGE(PG8_SA(0, 0), cA, voffA); PG8_STAGE(PG8_SA(0, 1), cA + hstep, voffA);
        if (wr == 1) PG8_BAR;
        PG8_WAIT_V(2); PG8_BAR;
        PG8_STAGE(PG8_SB(1, 0), cB + kstep, voffB); PG8_STAGE(PG8_SA(1, 0), cA + kstep, voffA); PG8_STAGE(PG8_SB(1, 1), cB + hstep + kstep, voffB);
        PG8_WAIT_V(6); PG8_BAR;
    } else {
        PG8_STAGE(PG8_SB(0, 0), cB, voffB); PG8_STAGE(PG8_SA(0, 0), cA, voffA); PG8_STAGE(PG8_SB(0, 1), cB + hstep, voffB); PG8_STAGE(PG8_SA(0, 1), cA + hstep, voffA);
        if (wr == 1) PG8_BAR;
        PG8_WAIT_V(4); PG8_BAR;
        PG8_STAGE(PG8_SB(1, 0), cB + kstep, voffB); PG8_STAGE(PG8_SA(1, 0), cA + kstep, voffA); PG8_STAGE(PG8_SB(1, 1), cB + hstep + kstep, voffB);
        PG8_WAIT_V(6); PG8_BAR;
    }
    for (;;) {
        const bool has_next = S.next(ui + 1, nxt);
        const char* nA = has_next ? (const char*)g.A + (size_t)nxt.pm * tstep : cA; const char* nB = has_next ? (const char*)g.Bt + (size_t)nxt.pn * tstep : cB;
        for (int t = 0; t < nt; t += 2) {
            const bool last = (t == nt - 2);
            const char* a1 = cA + (size_t)(t + 1) * kstep;
            const char* a2 = last ? nA : cA + (size_t)(t + 2) * kstep; const char* b2 = last ? nB : cB + (size_t)(t + 2) * kstep;
            const char* a3 = a2 + kstep; const char* b3 = b2 + kstep;
            if (last && has_next) S.a_ready(nxt);
            if constexpr (SP2) {
            PG8_LDB(B0, 0, 0); PG8_LDB(B1, 0, 1); PG8_SCHED; PG8_LDA(At, 0, 0); PG8_STAGE(PG8_SA(1, 1), a1 + hstep, voffA);
            PG8_WAIT_V(8); PG8_WAIT_L(0); PG8_BAR; PG8_MMA(0, 0, At, B0); PG8_MMA(0, 1, At, B1); PG8_BAR; PG8_SCHED;
            PG8_LDA(At, 0, 1); PG8_STAGE(PG8_SB(0, 0), b2, voffB); PG8_STAGE(PG8_SB(0, 1), b2 + hstep, voffB); PG8_STAGE(PG8_SA(0, 0), a2, voffA);
            PG8_WAIT_V(8); PG8_WAIT_L(0); PG8_BAR; PG8_MMA(1, 0, At, B0); PG8_MMA(1, 1, At, B1); PG8_BAR; PG8_SCHED;
            PG8_LDB(B0, 1, 0); PG8_LDB(B1, 1, 1); PG8_SCHED; PG8_LDA(At, 1, 0); PG8_STAGE(PG8_SA(0, 1), a2 + hstep, voffA);
            PG8_WAIT_V(8); PG8_WAIT_L(0); PG8_BAR; PG8_MMA(0, 0, At, B0); PG8_MMA(0, 1, At, B1); PG8_BAR; PG8_SCHED;
            PG8_LDA(At, 1, 1); PG8_STAGE(PG8_SB(1, 0), b3, voffB); PG8_STAGE(PG8_SB(1, 1), b3 + hstep, voffB); PG8_STAGE(PG8_SA(1, 0), a3, voffA);
            PG8_WAIT_V(8); PG8_WAIT_L(0); PG8_BAR; PG8_MMA(1, 0, At, B0); PG8_MMA(1, 1, At, B1); PG8_BAR; PG8_SCHED;
            } else {
            PG8_LDB(B0, 0, 0); PG8_SCHED; PG8_LDA(At, 0, 0); PG8_STAGE(PG8_SA(1, 1), a1 + hstep, voffA);
            PG8_WAIT_L(8); PG8_BAR; PG8_WAIT_L(0); PG8_MMA(0, 0, At, B0); PG8_BAR; PG8_SCHED;
            PG8_LDB(B1, 0, 1); PG8_STAGE(PG8_SB(0, 0), b2, voffB);
            PG8_BAR; PG8_WAIT_L(0); PG8_MMA(0, 1, At, B1); PG8_BAR;
            PG8_LDA(At, 0, 1); PG8_STAGE(PG8_SA(0, 0), a2, voffA);
            PG8_BAR; PG8_WAIT_L(0); PG8_MMA(1, 0, At, B0); PG8_BAR; PG8_SCHED;
            PG8_STAGE(PG8_SB(0, 1), b2 + hstep, voffB);
            PG8_WAIT_V(6); PG8_BAR; PG8_MMA(1, 1, At, B1); PG8_BAR;
            PG8_LDB(B0, 1, 0); PG8_SCHED; PG8_LDA(At, 1, 0); PG8_STAGE(PG8_SA(0, 1), a2 + hstep, voffA);
            PG8_WAIT_L(8); PG8_BAR; PG8_WAIT_L(0); PG8_MMA(0, 0, At, B0); PG8_BAR; PG8_SCHED;
            PG8_LDB(B1, 1, 1); PG8_STAGE(PG8_SB(1, 0), b3, voffB);
            PG8_BAR; PG8_WAIT_L(0); PG8_MMA(0, 1, At, B1); PG8_BAR;
            PG8_LDA(At, 1, 1); PG8_STAGE(PG8_SA(1, 0), a3, voffA);
            PG8_BAR; PG8_WAIT_L(0); PG8_MMA(1, 0, At, B0); PG8_BAR; PG8_SCHED;
            PG8_STAGE(PG8_SB(1, 1), b3 + hstep, voffB);
            PG8_WAIT_V(6); PG8_BAR; PG8_MMA(1, 1, At, B1); PG8_BAR;
            }
        }
        if constexpr (ALIGN_EPI) { if (wr == 0) PG8_BAR; }
        if constexpr (!Epi::AFTER_DRAIN) { E(acc, cur, wr, wc, fr, fq); S.done(cur); }
        if (!has_next) break;
#pragma unroll
        for (int a = 0; a < 2; ++a)
#pragma unroll
            for (int b = 0; b < 2; ++b)
#pragma unroll
                for (int m = 0; m < 4; ++m)
#pragma unroll
                    for (int n = 0; n < 2; ++n) acc[a][b][m][n] = (f32x4){0.f, 0.f, 0.f, 0.f};
        cur = nxt; cA = nA; cB = nB; ++ui;
        if constexpr (ALIGN_EPI) { if (wr == 1) PG8_BAR; }
    }
    PG8_WAIT_V(0);
    if constexpr (!ALIGN_EPI) { if (wr == 0) PG8_BAR; }
    PG8_BAR;
    if constexpr (Epi::AFTER_DRAIN) { E.fused(acc, cur, wr, wc, fr, fq, lds, wid, lane); S.done(cur); }
#undef PG8_SA
#undef PG8_SB
#undef PG8_STAGE
#undef PG8_LDA
#undef PG8_LDB
#undef PG8_MMA
#undef PG8_WAIT_V
#undef PG8_WAIT_L
#undef PG8_BAR
#undef PG8_SCHED
}
}

#define DI __device__ __forceinline__
#define LAS __attribute__((address_space(3)))
typedef unsigned short bf16;
typedef unsigned v4u __attribute__((ext_vector_type(4)));
typedef unsigned v2u __attribute__((ext_vector_type(2)));
typedef float f32x4 __attribute__((ext_vector_type(4)));
typedef float f32x16 __attribute__((ext_vector_type(16)));
typedef short bf16x8 __attribute__((ext_vector_type(8)));
typedef short s16x4 __attribute__((ext_vector_type(4)));
using pg8::pk2; using pg8::bflo; using pg8::bfhi; using pg8::sigm;

constexpr int NWAVES = 8, NTHR = 512;
constexpr int DM = 1024, BATCH = 4, SEQ = 8192, T = BATCH * SEQ, DEPTH = 2, DFF = 2816;
constexpr int QL = 352, QLP = 384, KVL = 128, WIN = 6144, NMOD = 9;
constexpr float EPS = 1e-6f;
constexpr float C2 = 0.10206207261596577f * 1.4426950408889634f;
constexpr int LDS_BYTES = 131072 + 1024;

constexpr size_t MiB = 1u << 20;
constexpr size_t WS_MOD = 0;
constexpr size_t WS_COS = 512 * 1024, WS_SIN = 1 * MiB;
constexpr size_t WS_TW = 1536 * 1024;
constexpr size_t WS_WDFTC = 1792 * 1024;
constexpr size_t WS_WFFTA = 2 * MiB;
constexpr size_t WS_W64 = 2 * MiB + 256 * 1024;
constexpr size_t WS_BAR = 3 * MiB, BAR_ZERO_BYTES = 16384;
constexpr size_t WS_W = 4 * MiB;
constexpr size_t W_FFN_IN = 0, W_FFN_OUT = 11 * MiB, W_FFN_STRIDE = 16 * MiB + 512 * 1024;
constexpr size_t W_MIXIN = 33 * MiB;
constexpr size_t W_UQ = 45 * MiB;
constexpr size_t W_UKV = 45 * MiB + 640 * 1024;
constexpr size_t W_A = 46 * MiB, W_B = 47 * MiB, W_C = 47 * MiB + 512 * 1024, W_D = 48 * MiB + 512 * 1024, W_OUT = 49 * MiB + 512 * 1024;
constexpr size_t WS_H = 56 * MiB;
constexpr size_t WS_O = 120 * MiB, WS_YB = 152 * MiB, WS_DP = 168 * MiB, WS_F = 200 * MiB;
constexpr size_t WS_TMP = 232 * MiB;
constexpr size_t WS_ACT = WS_TMP, WS_Y = 408 * MiB;
constexpr size_t WS_ZA = 232 * MiB, WS_U = 264 * MiB, WS_ZC = 280 * MiB, WS_ZD = 312 * MiB, WS_CQN = 344 * MiB, WS_CKVN = 368 * MiB, WS_KR = 376 * MiB;
constexpr size_t WS_Q = 380 * MiB, WS_KN = 428 * MiB, WS_VT = 460 * MiB;
constexpr size_t WS_ZT = 232 * MiB, WS_YP = 296 * MiB, WS_GATES = 232 * MiB;
constexpr size_t WS_END = 512 * MiB;

struct Args { const float* in[25]; float* out; unsigned char* ws; };

struct Ctx { int tid, lane, wave, G, bid; LAS unsigned char* lds; };


#define GAS __attribute__((address_space(1)))
#define XB_TMO      128
#define XB_XCNT(j)  (256  + 64 * (j))
#define XB_XSUB(j)  (1280 + 64 * (j))
#define XB_XGEN(j)  (2304 + 64 * (j))
#define XB_TOP      3328
#define XB_TOPGEN   3392
#define XCD_BAR_WORDS 3456
#define XB_SPIN_CAP (1u << 18)

__device__ __forceinline__ unsigned xb_ld(unsigned* p)              { return __hip_atomic_load(p, __ATOMIC_RELAXED, __HIP_MEMORY_SCOPE_AGENT); }
__device__ __forceinline__ unsigned xb_add(unsigned* p, unsigned v) { return __hip_atomic_fetch_add(p, v, __ATOMIC_RELAXED, __HIP_MEMORY_SCOPE_AGENT); }
__device__ __forceinline__ unsigned xb_xcc_id() { return (unsigned)__builtin_amdgcn_s_getreg((3 << 11) | 20) & 0xFu; }
#define XB_SPIN(cond, bar) do { unsigned _sp = 0; while (cond) { __builtin_amdgcn_s_sleep(1); \
    if ((++_sp & 255u) == 0u) { if (xb_ld(&(bar)[XB_TMO])) break; if (_sp > XB_SPIN_CAP) { atomicAdd(&(bar)[XB_TMO], 1u); break; } } } } while (0)

struct XcdBarrier {
    unsigned* bar; unsigned x;
    volatile LAS unsigned* st;
};

__device__ __forceinline__ XcdBarrier xcd_barrier_post(unsigned* bar, volatile LAS unsigned* st) {
    XcdBarrier b; b.bar = bar; b.x = xb_xcc_id(); b.st = st;
    if (threadIdx.x == 0) (void)xb_add(&bar[XB_XCNT(b.x)], 1u);
    return b;
}
__device__ __forceinline__ void xcd_barrier_complete(unsigned* bar, unsigned x, unsigned& nloc, unsigned& nx) {
    const unsigned G = gridDim.x * gridDim.y * gridDim.z;
    unsigned sum, cnt, mine, sp = 0u;
    for (;;) {
        sum = 0u; cnt = 0u; mine = 0u;
#pragma unroll
        for (unsigned j = 0; j < 16; ++j) { const unsigned c = xb_ld(&bar[XB_XCNT(j)]); sum += c; cnt += (c > 0u) ? 1u : 0u; mine = (j == x) ? c : mine; }
        if (sum == G) break;
        __builtin_amdgcn_s_sleep(1);
        if ((++sp & 255u) == 0u) { if (xb_ld(&bar[XB_TMO])) break; if (sp > XB_SPIN_CAP) { atomicAdd(&bar[XB_TMO], 1u); break; } }
    }
    nloc = mine > 0u ? mine : 1u; nx = cnt > 0u ? cnt : 1u;
}

__device__ __forceinline__ void xcd_barrier(const XcdBarrier& b) {
    asm volatile("s_waitcnt vmcnt(0)" ::: "memory");
    __syncthreads();
    if (threadIdx.x == 0) {
        unsigned* bar = b.bar;
        __builtin_amdgcn_s_waitcnt(0);
        unsigned nloc = b.st[0], nx = b.st[1];
        if (nloc == 0u) { xcd_barrier_complete(bar, b.x, nloc, nx); b.st[0] = nloc; b.st[1] = nx; }
        const unsigned old = xb_add(&bar[XB_XSUB(b.x)], 1u);
        const unsigned gen = old / nloc;
        if (old + 1u == (gen + 1u) * nloc) {
            __builtin_amdgcn_fence(__ATOMIC_RELEASE, "agent");
            asm volatile("s_waitcnt vmcnt(0)" ::: "memory");
            const unsigned og = xb_add(&bar[XB_TOP], 1u);
            const unsigned tg = og / nx;
            if (og + 1u == (tg + 1u) * nx) xb_add(&bar[XB_TOPGEN], 1u);
            else XB_SPIN(xb_ld(&bar[XB_TOPGEN]) == tg, bar);
            __builtin_amdgcn_fence(__ATOMIC_ACQUIRE, "agent");
            xb_add(&bar[XB_XGEN(b.x)], 1u);
            asm volatile("s_waitcnt vmcnt(0)" ::: "memory");
        } else {
            XB_SPIN(xb_ld(&bar[XB_XGEN(b.x)]) == gen, bar);
            __builtin_amdgcn_fence(__ATOMIC_ACQUIRE, "agent");
            asm volatile("s_waitcnt vmcnt(0)" ::: "memory");
        }
    }
    __syncthreads();
}

DI float wave_sum(float v) {
#pragma unroll
    for (int o = 1; o < 64; o <<= 1) v += __shfl_xor(v, o);
    return v;
}
DI void sincos_turns(double turns, float& sn, float& cs) {
    const double r = turns - __builtin_rint(turns);
    const double x = r * 6.283185307179586476925287, x2 = x * x;
    double ts = x, tc = 1.0, s = x, c = 1.0;
#pragma unroll 1
    for (int k = 1; k <= 14; ++k) { tc = -tc * x2 / (double)((2 * k - 1) * (2 * k)); c += tc; ts = -ts * x2 / (double)((2 * k) * (2 * k + 1)); s += ts; }
    sn = (float)s; cs = (float)c;
}

DI void transpose_item(const float* W, int Kreal, int N, bf16* WT, int Kpad, int mode, LAS float* scr, int item, int lane) {
    const int nblk = N / 32, kb = item / nblk, nb = item % nblk, k0 = 64 * kb, n0 = 32 * nb;
#pragma unroll 8
    for (int i = 0; i < 32; ++i) { const int kk = 2 * i + (lane >> 5); scr[kk * 33 + (lane & 31)] = (k0 + kk < Kreal) ? W[(size_t)(k0 + kk) * N + n0 + (lane & 31)] : 0.f; }
    asm volatile("s_waitcnt lgkmcnt(0)" ::: "memory");
    int r0;
    if (mode == 1) { const int half = N / 2; const int j = n0 >= half ? n0 - half : n0; r0 = (j >> 7) * 256 + (n0 >= half ? 128 : 0) + (j & 127); }
    else if (mode == 2) { if (n0 >= 512 && n0 < 1024) { const int j = (n0 - 512) & 255, gt = (n0 - 512) >> 8; r0 = 512 + (j >> 7) * 256 + gt * 128 + (j & 127); } else r0 = n0; }
    else if (mode == 3) { const int hd = n0 >> 7, c = n0 & 127; r0 = (c >= 64 ? 512 : 0) + hd * 64 + (c & 63); }
    else r0 = n0;
    const int c = lane & 7;
#pragma unroll
    for (int j = 0; j < 4; ++j) { const int n = (lane >> 3) + 8 * j; const LAS float* s = scr + (8 * c) * 33 + n;
        v4u o; o.x = pk2(s[0 * 33], s[1 * 33]); o.y = pk2(s[2 * 33], s[3 * 33]); o.z = pk2(s[4 * 33], s[5 * 33]); o.w = pk2(s[6 * 33], s[7 * 33]);
        *(v4u*)(WT + (size_t)(r0 + n) * Kpad + k0 + 8 * c) = o; }
    asm volatile("s_waitcnt lgkmcnt(0)" ::: "memory");
}

DI void convert_weights(const Ctx& F0, const Args& a, int l) {
    Ctx F = F0; asm volatile("" : "+v"(F.tid), "+v"(F.lane));
    LAS float* scr = (LAS float*)(F.lds + F.wave * 16384);
    bf16* Wb = (bf16*)(a.ws + WS_W);
    const int gw = F.bid * NWAVES + F.wave, NGW = F.G * NWAVES;
    constexpr int I_FI = 16 * 176, I_FO = 44 * 32, I_MI = 16 * 192, I_UQ = 6 * 24, I_UKV = 2 * 32, I_A = 8 * 32, I_B = 4 * 32, I_D = 8 * 32, I_O = 16 * 32;
    constexpr int NITEMS = 2 * I_FI + 2 * I_FO + I_MI + I_UQ + I_UKV + I_A + I_B + I_D + I_O;
    for (int it = gw; it < NITEMS; it += NGW) {
        int r = it;
        if (r < I_FI) { transpose_item(a.in[5] + (size_t)l * DM * 2 * DFF, DM, 2 * DFF, Wb + (W_FFN_IN) / 2, DM, 1, scr, r, F.lane); continue; } r -= I_FI;
        if (r < I_FI) { transpose_item(a.in[7] + (size_t)l * DM * 2 * DFF, DM, 2 * DFF, Wb + (W_FFN_STRIDE + W_FFN_IN) / 2, DM, 1, scr, r, F.lane); continue; } r -= I_FI;
        if (r < I_FO) { transpose_item(a.in[6] + (size_t)l * DFF * DM, DFF, DM, Wb + (W_FFN_OUT) / 2, DFF, 0, scr, r, F.lane); continue; } r -= I_FO;
        if (r < I_FO) { transpose_item(a.in[8] + (size_t)l * DFF * DM, DFF, DM, Wb + (W_FFN_STRIDE + W_FFN_OUT) / 2, DFF, 0, scr, r, F.lane); continue; } r -= I_FO;
        if (r < I_MI) { transpose_item(a.in[9] + (size_t)l * DM * WIN, DM, WIN, Wb + W_MIXIN / 2, DM, 2, scr, r, F.lane); continue; } r -= I_MI;
        if (r < I_UQ) { transpose_item(a.in[11] + (size_t)l * QL * 768, QL, 768, Wb + W_UQ / 2, QLP, 0, scr, r, F.lane); continue; } r -= I_UQ;
        if (r < I_UKV) { transpose_item(a.in[13] + (size_t)l * KVL * 1024, KVL, 1024, Wb + W_UKV / 2, KVL, 3, scr, r, F.lane); continue; } r -= I_UKV;
        if (r < I_A) { transpose_item(a.in[14] + (size_t)l * 512 * DM, 512, DM, Wb + W_A / 2, 512, 0, scr, r, F.lane); continue; } r -= I_A;
        if (r < I_B) { transpose_item(a.in[19] + (size_t)l * 256 * DM, 256, DM, Wb + W_B / 2, 256, 0, scr, r, F.lane); continue; } r -= I_B;
        if (r < I_D) { transpose_item(a.in[23] + (size_t)l * 512 * DM, 512, DM, Wb + W_D / 2, 512, 0, scr, r, F.lane); continue; } r -= I_D;
        transpose_item(a.in[24] + (size_t)l * DM * DM, DM, DM, Wb + W_OUT / 2, DM, 0, scr, r, F.lane);
    }
    const float* pw = a.in[20] + (size_t)l * 4 * 128 * 128; const float* ps = a.in[21] + (size_t)l * 512; const float* wc = a.in[22] + (size_t)l * 512 * DM;
    bf16* WcT = Wb + W_C / 2;
    for (int o = F.bid * NTHR + F.tid; o < 512 * DM; o += F.G * NTHR) {
        const int n = o & 1023, k = o >> 10, g = k >> 7;
        const float* pr = pw + (size_t)k * 128; const float* sc = ps + g * 128; const float* wr = wc + (size_t)(g * 128) * DM + n;
        float acc = 0.f;
#pragma unroll 4
        for (int d = 0; d < 128; ++d) acc += pr[d] * sc[d] * wr[(size_t)d * DM];
        WcT[(size_t)n * 512 + k] = (bf16)(pk2(acc, 0.f) & 0xffffu);
    }
}

DI void build_tables(const Ctx& F, const Args& a) {
    const int gt = F.bid * NTHR + F.tid, NT_ = F.G * NTHR;
    float* cosT = (float*)(a.ws + WS_COS); float* sinT = (float*)(a.ws + WS_SIN);
    for (int o = gt; o < SEQ * 16; o += NT_) { const int s = o >> 4, i = o & 15;
        const float inv = __builtin_amdgcn_exp2f(-(float)i * (13.287712379549449f / 16.0f));
        const float ang = (float)s * inv; float sn, cs; sincos_turns((double)ang * 0.15915494309189533577, sn, cs); cosT[o] = cs; sinT[o] = sn; }
    float* tw = (float*)(a.ws + WS_TW);
    for (int o = gt; o < 8192; o += NT_) { float sn, cs; sincos_turns((double)o / 8192.0, sn, cs); tw[2 * o] = cs; tw[2 * o + 1] = sn; }
    bf16* wdc = (bf16*)(a.ws + WS_WDFTC);
    for (int o = gt; o < 256 * 128; o += NT_) { const int m = o >> 7, c = o & 127, ri = m >> 7, kc = m & 127; float sn, cs; sincos_turns((double)((kc * c) & 127) / 128.0, sn, cs);
        const float v = (ri == 0 ? cs : -sn) * 0.08838834764831845f; wdc[o] = (bf16)(pk2(v, 0.f) & 0xffffu); }
    bf16* wfa = (bf16*)(a.ws + WS_WFFTA);
    for (int o = gt; o < 256 * 256; o += NT_) { const int m = o >> 8, k = o & 255, rp = m >> 7, k1 = m & 127, ri = k >> 7, s1 = k & 127; float sn, cs; sincos_turns((double)((k1 * s1) & 127) / 128.0, sn, cs);
        const float v = (rp == ri ? cs : (rp == 0 ? sn : -sn)) * 0.08838834764831845f; wfa[o] = (bf16)(pk2(v, 0.f) & 0xffffu); }
    bf16* w64 = (bf16*)(a.ws + WS_W64);
    for (int o = gt; o < 256 * 128; o += NT_) { const int m = o >> 7, k = o & 127, ri = k >> 6, s2 = k & 63; float sn, cs; sincos_turns((double)((m * s2) & 63) / 64.0, sn, cs);
        const float v = m < 64 ? (ri == 0 ? cs : sn) * 0.125f : 0.f; w64[o] = (bf16)(pk2(v, 0.f) & 0xffffu); }
}

DI void compute_mod(const Ctx& F, const Args& a) {
    LAS float* sc = (LAS float*)F.lds;
    LAS float* part = (LAS float*)(F.lds + 16384);
    const float* c = a.in[1];
    for (int i = F.tid; i < 4 * DM; i += NTHR) { const float v = c[i]; sc[i] = v * sigm(v); }
    __syncthreads();
    float* mod = (float*)(a.ws + WS_MOD);
    for (int it = F.bid; it < DEPTH * 144; it += F.G) {
        const int l = it / 144, j0 = (it % 144) * 64, j = j0 + F.lane;
        const float* w = a.in[2] + (size_t)l * DM * (NMOD * DM) + j;
        float a0 = 0.f, a1 = 0.f, a2 = 0.f, a3 = 0.f;
        const int kb = F.wave * 128;
#pragma unroll 4
        for (int k = 0; k < 128; ++k) { const float wv = w[(size_t)(kb + k) * (NMOD * DM)]; a0 += sc[kb + k] * wv; a1 += sc[1024 + kb + k] * wv; a2 += sc[2048 + kb + k] * wv; a3 += sc[3072 + kb + k] * wv; }
        part[(F.wave * 4 + 0) * 64 + F.lane] = a0; part[(F.wave * 4 + 1) * 64 + F.lane] = a1; part[(F.wave * 4 + 2) * 64 + F.lane] = a2; part[(F.wave * 4 + 3) * 64 + F.lane] = a3;
        __syncthreads();
        if (F.wave < 4) { float s = a.in[3][(size_t)l * NMOD * DM + j];
#pragma unroll
            for (int w8 = 0; w8 < 8; ++w8) s += part[(w8 * 4 + F.wave) * 64 + F.lane];
            mod[((size_t)l * 4 + F.wave) * (NMOD * DM) + j] = s; }
        __syncthreads();
    }
}

DI void rowwise(const Ctx& F0, const float* xin, const bf16* y, float ymul, const float* gate, const float* gy, float* xout,
                const float* gn, const float* shift, const float* scale, bf16* H, bool has_y, bool has_next) {
    Ctx F = F0; asm volatile("" : "+v"(F.tid), "+v"(F.lane));
    const int gw = F.bid * NWAVES + F.wave, NGW = F.G * NWAVES;
    for (int rb = gw; rb < T; rb += 2 * NGW) {
        f32x4 x[2][4]; f32x4 yv[2][4];
#pragma unroll
        for (int u = 0; u < 2; ++u) { const int r = rb + u * NGW; if (r < T) { const size_t ro = (size_t)r * DM;
#pragma unroll
            for (int j = 0; j < 4; ++j) x[u][j] = *(const f32x4*)(xin + ro + 4 * F.lane + 256 * j);
            if (has_y) {
#pragma unroll
                for (int j = 0; j < 4; ++j) { const v2u w = *(const v2u*)(y + ro + 4 * F.lane + 256 * j); yv[u][j] = (f32x4){bflo(w.x), bfhi(w.x), bflo(w.y), bfhi(w.y)}; } } } }
#pragma unroll
        for (int u = 0; u < 2; ++u) { const int r = rb + u * NGW; if (r < T) { const int b = r >> 13; const size_t ro = (size_t)r * DM;
            if (has_y) {
                float ss = 0.f;
#pragma unroll
                for (int j = 0; j < 4; ++j) ss += (yv[u][j][0] * yv[u][j][0] + yv[u][j][1] * yv[u][j][1]) + (yv[u][j][2] * yv[u][j][2] + yv[u][j][3] * yv[u][j][3]);
                const float ry = __builtin_amdgcn_rsqf(wave_sum(ss) * (1.0f / DM) + EPS) * ymul;
#pragma unroll
                for (int j = 0; j < 4; ++j) { const int c = 4 * F.lane + 256 * j; const f32x4 gt = *(const f32x4*)(gate + (size_t)b * (NMOD * DM) + c), gg = *(const f32x4*)(gy + c);
                    x[u][j] += gt * (yv[u][j] * ry * gg); }
            }
#pragma unroll
            for (int j = 0; j < 4; ++j) *(f32x4*)(xout + ro + 4 * F.lane + 256 * j) = x[u][j];
            if (has_next) {
                float ss = 0.f;
#pragma unroll
                for (int j = 0; j < 4; ++j) ss += (x[u][j][0] * x[u][j][0] + x[u][j][1] * x[u][j][1]) + (x[u][j][2] * x[u][j][2] + x[u][j][3] * x[u][j][3]);
                const float rx = __builtin_amdgcn_rsqf(wave_sum(ss) * (1.0f / DM) + EPS);
#pragma unroll
                for (int j = 0; j < 4; ++j) { const int c = 4 * F.lane + 256 * j;
                    const f32x4 gg = *(const f32x4*)(gn + c), sh = *(const f32x4*)(shift + (size_t)b * (NMOD * DM) + c), sc = *(const f32x4*)(scale + (size_t)b * (NMOD * DM) + c);
                    const f32x4 h = (x[u][j] * rx * gg) * (sc + 1.0f) + sh;
                    v2u w; w.x = pk2(h[0], h[1]); w.y = pk2(h[2], h[3]); *(v2u*)(H + ro + c) = w; }
            } } }
    }
}

DI void mixer_pre(const Ctx& F0, const Args& a, int l) {
    Ctx F = F0; asm volatile("" : "+v"(F.tid), "+v"(F.lane));
    const bf16* ZA = (const bf16*)(a.ws + WS_ZA); const bf16* U = (const bf16*)(a.ws + WS_U); const bf16* ZC = (const bf16*)(a.ws + WS_ZC);
    bf16* cqn = (bf16*)(a.ws + WS_CQN); bf16* ckvn = (bf16*)(a.ws + WS_CKVN); bf16* kr = (bf16*)(a.ws + WS_KR);
    bf16* yb = (bf16*)(a.ws + WS_YB); bf16* dp = (bf16*)(a.ws + WS_DP);
    const float* cosT = (const float*)(a.ws + WS_COS); const float* sinT = (const float*)(a.ws + WS_SIN);
    const float* qg = a.in[10] + (size_t)l * QL; const float* kvg = a.in[12] + (size_t)l * KVL;
    const int gw = F.bid * NWAVES + F.wave, NGW = F.G * NWAVES; const int lane = F.lane;
    for (int r = gw; r < T; r += NGW) {
        const int s = r & 8191;
        const v4u w = *(const v4u*)(ZA + (size_t)r * 512 + lane * 8);
        float f[8] = {bflo(w.x), bfhi(w.x), bflo(w.y), bfhi(w.y), bflo(w.z), bfhi(w.z), bflo(w.w), bfhi(w.w)};
        float ss = 0.f;
#pragma unroll
        for (int j = 0; j < 8; ++j) ss += f[j] * f[j];
        const float ssq = wave_sum(lane < 44 ? ss : 0.f), sskv = wave_sum((lane >= 44 && lane < 60) ? ss : 0.f);
        const float rq = __builtin_amdgcn_rsqf(ssq * (1.0f / QL) + EPS), rkv = __builtin_amdgcn_rsqf(sskv * (1.0f / KVL) + EPS);
        float oth[8];
#pragma unroll
        for (int j = 0; j < 8; ++j) oth[j] = __shfl_xor(f[j], 2);
        if (lane < 44) { const f32x4 g0 = *(const f32x4*)(qg + lane * 8), g1 = *(const f32x4*)(qg + lane * 8 + 4);
            v4u o; o.x = pk2(f[0] * rq * g0[0], f[1] * rq * g0[1]); o.y = pk2(f[2] * rq * g0[2], f[3] * rq * g0[3]); o.z = pk2(f[4] * rq * g1[0], f[5] * rq * g1[1]); o.w = pk2(f[6] * rq * g1[2], f[7] * rq * g1[3]);
            *(v4u*)(cqn + (size_t)r * QLP + lane * 8) = o;
        } else if (lane < 60) { const int c0 = (lane - 44) * 8; const f32x4 g0 = *(const f32x4*)(kvg + c0), g1 = *(const f32x4*)(kvg + c0 + 4);
            v4u o; o.x = pk2(f[0] * rkv * g0[0], f[1] * rkv * g0[1]); o.y = pk2(f[2] * rkv * g0[2], f[3] * rkv * g0[3]); o.z = pk2(f[4] * rkv * g1[0], f[5] * rkv * g1[1]); o.w = pk2(f[6] * rkv * g1[2], f[7] * rkv * g1[3]);
            *(v4u*)(ckvn + (size_t)r * KVL + c0) = o;
            if (lane < 48) { const v4u z = {0u, 0u, 0u, 0u}; *(v4u*)(cqn + (size_t)r * QLP + QL + (lane - 44) * 8) = z; }
        } else { const int hi2 = (lane >= 62), i0 = ((lane - 60) & 1) * 8;
            const f32x4 c0 = *(const f32x4*)(cosT + s * 16 + i0), c1 = *(const f32x4*)(cosT + s * 16 + i0 + 4), s0 = *(const f32x4*)(sinT + s * 16 + i0), s1 = *(const f32x4*)(sinT + s * 16 + i0 + 4);
            float o8[8];
#pragma unroll
            for (int j = 0; j < 8; ++j) { const float cc = j < 4 ? c0[j & 3] : c1[j & 3], sn = j < 4 ? s0[j & 3] : s1[j & 3];
                o8[j] = hi2 ? (oth[j] * sn + f[j] * cc) : (f[j] * cc - oth[j] * sn); }
            v4u o; o.x = pk2(o8[0], o8[1]); o.y = pk2(o8[2], o8[3]); o.z = pk2(o8[4], o8[5]); o.w = pk2(o8[6], o8[7]);
            *(v4u*)(kr + (size_t)r * 32 + hi2 * 16 + i0) = o; }
        { const int g = lane >> 4, wlen = 2 << g, lo = wlen >> 1; float sum[8] = {0.f, 0.f, 0.f, 0.f, 0.f, 0.f, 0.f, 0.f}; int cnt = 0;
          const bf16* zb = ZC + (size_t)(r - s) * 512 + lane * 8;
#pragma unroll 4
          for (int k = 0; k < 16; ++k) { const int sr = s - lo + k;
              if (k < wlen && sr >= 0 && sr < SEQ) { const v4u v = *(const v4u*)(zb + (size_t)sr * 512); ++cnt;
                  sum[0] += bflo(v.x); sum[1] += bfhi(v.x); sum[2] += bflo(v.y); sum[3] += bfhi(v.y); sum[4] += bflo(v.z); sum[5] += bfhi(v.z); sum[6] += bflo(v.w); sum[7] += bfhi(v.w); } }
          const v4u v = *(const v4u*)(zb + (size_t)s * 512); const float ic = 1.0f / (float)cnt;
          v4u o; o.x = pk2(sum[0] * ic - bflo(v.x), sum[1] * ic - bfhi(v.x)); o.y = pk2(sum[2] * ic - bflo(v.y), sum[3] * ic - bfhi(v.y));
          o.z = pk2(sum[4] * ic - bflo(v.z), sum[5] * ic - bfhi(v.z)); o.w = pk2(sum[6] * ic - bflo(v.w), sum[7] * ic - bfhi(v.w));
          *(v4u*)(dp + (size_t)r * 512 + lane * 8) = o; }
    }
    LAS float* lu = (LAS float*)F.lds;
    LAS float* ly = (LAS float*)(F.lds + 62 * 256 * 4);
    const float* cw = a.in[15] + (size_t)l * 31 * 256; const float* cb = a.in[16] + (size_t)l * 256;
    const float* lg = a.in[17] + (size_t)l * 256; const float* lb = a.in[18] + (size_t)l * 256;
    const int ch = F.tid & 255, part = F.tid >> 8;
    float wreg[31];
#pragma unroll
    for (int j = 0; j < 31; ++j) wreg[j] = cw[j * 256 + ch];
    const float bias = cb[ch];
    for (int tile = F.bid; tile < T / 32; tile += F.G) {
        const int t0 = tile * 32, s0 = t0 & 8191, tb = t0 - s0;
        for (int c = F.tid; c < 62 * 32; c += NTHR) { const int row = c >> 5, cc = c & 31, sr = s0 - 15 + row;
            v4u v = {0u, 0u, 0u, 0u}; if (sr >= 0 && sr < SEQ) v = *(const v4u*)(U + (size_t)(tb + sr) * 256 + cc * 8);
            LAS float* d = lu + row * 256 + cc * 8;
            *(LAS f32x4*)d = (f32x4){bflo(v.x), bfhi(v.x), bflo(v.y), bfhi(v.y)}; *(LAS f32x4*)(d + 4) = (f32x4){bflo(v.z), bfhi(v.z), bflo(v.w), bfhi(v.w)}; }
        __syncthreads();
#pragma unroll 2
        for (int tk = 0; tk < 16; ++tk) { const int tok = part * 16 + tk; float acc = bias;
#pragma unroll
            for (int j = 0; j < 31; ++j) acc += wreg[j] * lu[(tok + j) * 256 + ch];
            ly[tok * 256 + ch] = acc; }
        __syncthreads();
#pragma unroll
        for (int q = 0; q < 4; ++q) { const int tok = F.wave * 4 + q; const f32x4 v = *(const LAS f32x4*)(ly + tok * 256 + lane * 4);
            const float mean = wave_sum((v[0] + v[1]) + (v[2] + v[3])) * (1.0f / 256.0f); const f32x4 d = v - mean;
            const float var = wave_sum((d[0] * d[0] + d[1] * d[1]) + (d[2] * d[2] + d[3] * d[3])) * (1.0f / 256.0f);
            const float rs = __builtin_amdgcn_rsqf(var + EPS);
            const f32x4 yn = d * rs * *(const f32x4*)(lg + lane * 4) + *(const f32x4*)(lb + lane * 4);
            v2u o; o.x = pk2(yn[0] * sigm(yn[0]), yn[1] * sigm(yn[1])); o.y = pk2(yn[2] * sigm(yn[2]), yn[3] * sigm(yn[3]));
            *(v2u*)(yb + (size_t)(t0 + tok) * 256 + lane * 4) = o; }
        __syncthreads();
    }
}

constexpr int AK_ROW = 208, AV_ROW = 136, AK_BUF = 64 * AK_ROW, AV_BUF = 64 * AV_ROW;
DI void attn_phase(const Ctx& F0, const bf16* Q, const bf16* Kn, const bf16* Kr, const bf16* Vt, bf16* O) {
    Ctx F = F0; asm volatile("" : "+v"(F.tid), "+v"(F.lane));
    const int tid = F.tid, lane = F.lane, wid = F.wave, r = lane & 31, h = lane >> 5;
    LAS unsigned char* lds = F.lds;
    for (int un = F.bid; un < 1024; un += F.G) {
        const int bh = (un & 7) + 8 * (un >> 8), qb = (un >> 3) & 31, b = bh >> 3, hd = bh & 7;
        const bf16* Qp = Q + ((size_t)bh * SEQ + qb * 256 + wid * 32 + r) * 96 + h * 8;
        bf16x8 qr[6];
#pragma unroll
        for (int d0 = 0; d0 < 6; ++d0) qr[d0] = *(const bf16x8*)(Qp + d0 * 16);
        const bf16* kn_src = Kn + ((size_t)bh * SEQ + (tid >> 3)) * 64 + (tid & 7) * 8;
        const bf16* kr_src = Kr + ((size_t)b * SEQ + ((tid & 255) >> 2)) * 32 + (tid & 3) * 8;
        const bf16* v_src = Vt + ((size_t)bh * 64 + (tid >> 3)) * SEQ + (tid & 7) * 8;
        const int kn_dst = (tid >> 3) * AK_ROW + (tid & 7) * 16, kr_dst = ((tid & 255) >> 2) * AK_ROW + 128 + (tid & 3) * 16, v_dst = 2 * AK_BUF + (tid >> 3) * AV_ROW + (tid & 7) * 16;
        v4u g0, g1, g2;
        g0 = *(const v4u*)kn_src; g1 = *(const v4u*)kr_src; g2 = *(const v4u*)v_src;
        *(LAS v4u*)(lds + kn_dst) = g0; if (tid < 256) *(LAS v4u*)(lds + kr_dst) = g1;
        *(LAS v2u*)(lds + v_dst) = (v2u){g2.x, g2.y}; *(LAS v2u*)(lds + v_dst + 8) = (v2u){g2.z, g2.w};
        __syncthreads();
        f32x16 o0, o1, negm;
#pragma unroll
        for (int i = 0; i < 16; ++i) { o0[i] = 0.f; o1[i] = 0.f; negm[i] = 0.f; }
        float lrun = 0.f;
#pragma unroll 1
        for (int t = 0; t < SEQ / 64; ++t) {
            const int cur = t & 1, nxt = cur ^ 1; const bool more = (t + 1 < SEQ / 64);
            if (more) { g0 = *(const v4u*)(kn_src + (size_t)(t + 1) * 64 * 64); g1 = *(const v4u*)(kr_src + (size_t)(t + 1) * 64 * 32); g2 = *(const v4u*)(v_src + (t + 1) * 64); }
            const LAS unsigned char* kb = lds + cur * AK_BUF + r * AK_ROW + h * 16;
            const LAS unsigned char* vb = lds + 2 * AK_BUF + cur * AV_BUF + r * AV_ROW + h * 8;
            f32x16 p0 = negm, p1 = negm;
#pragma unroll
            for (int d0 = 0; d0 < 6; ++d0) { const bf16x8 a0 = *(const LAS bf16x8*)(kb + d0 * 32), a1 = *(const LAS bf16x8*)(kb + 32 * AK_ROW + d0 * 32);
                p0 = __builtin_amdgcn_mfma_f32_32x32x16_bf16(a0, qr[d0], p0, 0, 0, 0); p1 = __builtin_amdgcn_mfma_f32_32x32x16_bf16(a1, qr[d0], p1, 0, 0, 0); }
            float mx = __builtin_fmaxf(__builtin_fmaxf(p0[0], p0[1]), p1[0]);
#pragma unroll
            for (int i = 2; i < 16; i += 2) mx = __builtin_fmaxf(__builtin_fmaxf(mx, p0[i]), p0[i + 1]);
#pragma unroll
            for (int i = 1; i < 15; i += 2) mx = __builtin_fmaxf(__builtin_fmaxf(mx, p1[i]), p1[i + 1]);
            mx = __builtin_fmaxf(mx, p1[15]);
            mx = __builtin_fmaxf(mx, __shfl_xor(mx, 32));
            if (t == 0 || __any(mx > 8.0f)) {
                const float dl = (t == 0) ? mx : __builtin_fmaxf(mx, 0.f), f = (t == 0) ? 1.0f : __builtin_amdgcn_exp2f(-dl);
#pragma unroll
                for (int i = 0; i < 16; ++i) { p0[i] -= dl; p1[i] -= dl; negm[i] -= dl; o0[i] *= f; o1[i] *= f; }
                lrun *= f;
            }
            float ps0 = 0.f, ps1 = 0.f;
#pragma unroll
            for (int i = 0; i < 16; ++i) { p0[i] = __builtin_amdgcn_exp2f(p0[i]); p1[i] = __builtin_amdgcn_exp2f(p1[i]); ps0 += p0[i]; ps1 += p1[i]; }
            lrun += ps0 + ps1;
#pragma unroll
            for (int st = 0; st < 4; ++st) {
                v4u pw;
                if (st == 0) { pw.x = pk2(p0[0], p0[1]); pw.y = pk2(p0[2], p0[3]); pw.z = pk2(p0[4], p0[5]); pw.w = pk2(p0[6], p0[7]); }
                else if (st == 1) { pw.x = pk2(p0[8], p0[9]); pw.y = pk2(p0[10], p0[11]); pw.z = pk2(p0[12], p0[13]); pw.w = pk2(p0[14], p0[15]); }
                else if (st == 2) { pw.x = pk2(p1[0], p1[1]); pw.y = pk2(p1[2], p1[3]); pw.z = pk2(p1[4], p1[5]); pw.w = pk2(p1[6], p1[7]); }
                else { pw.x = pk2(p1[8], p1[9]); pw.y = pk2(p1[10], p1[11]); pw.z = pk2(p1[12], p1[13]); pw.w = pk2(p1[14], p1[15]); }
                const bf16x8 pb = __builtin_bit_cast(bf16x8, pw);
                const v2u va0 = *(const LAS v2u*)(vb + st * 32), va1 = *(const LAS v2u*)(vb + st * 32 + 16);
                const v2u vc0 = *(const LAS v2u*)(vb + 32 * AV_ROW + st * 32), vc1 = *(const LAS v2u*)(vb + 32 * AV_ROW + st * 32 + 16);
                const bf16x8 fa = __builtin_bit_cast(bf16x8, (v4u){va0.x, va0.y, va1.x, va1.y}), fc = __builtin_bit_cast(bf16x8, (v4u){vc0.x, vc0.y, vc1.x, vc1.y});
                o0 = __builtin_amdgcn_mfma_f32_32x32x16_bf16(fa, pb, o0, 0, 0, 0); o1 = __builtin_amdgcn_mfma_f32_32x32x16_bf16(fc, pb, o1, 0, 0, 0);
            }
            if (more) { *(LAS v4u*)(lds + nxt * AK_BUF + kn_dst) = g0; if (tid < 256) *(LAS v4u*)(lds + nxt * AK_BUF + kr_dst) = g1;
                *(LAS v2u*)(lds + nxt * AV_BUF + v_dst) = (v2u){g2.x, g2.y}; *(LAS v2u*)(lds + nxt * AV_BUF + v_dst + 8) = (v2u){g2.z, g2.w}; }
            __syncthreads();
        }
        const float ltot = lrun + __shfl_xor(lrun, 32), inv = 1.0f / ltot;
        bf16* Op = O + ((size_t)b * SEQ + qb * 256 + wid * 32 + r) * 512 + hd * 64 + 4 * h;
#pragma unroll
        for (int g = 0; g < 4; ++g) {
            v2u w0, w1; w0.x = pk2(o0[4 * g] * inv, o0[4 * g + 1] * inv); w0.y = pk2(o0[4 * g + 2] * inv, o0[4 * g + 3] * inv);
            w1.x = pk2(o1[4 * g] * inv, o1[4 * g + 1] * inv); w1.y = pk2(o1[4 * g + 2] * inv, o1[4 * g + 3] * inv);
            *(v2u*)(Op + 8 * g) = w0; *(v2u*)(Op + 32 + 8 * g) = w1; }
    }
}

template <class Epi> DI void run_gemm(const Ctx& F, const bf16* A, const bf16* Bt, int M, int N, int K, const Epi& E) {
    int Kv = K; asm volatile("" : "+s"(Kv)); pg8::Gemm g{A, Bt, M, N, Kv}; pg8::StaticOrder S; S.init(M, N, F.G, F.bid);
    pg8::gemm_phase<Epi, pg8::StaticOrder, true, true>((PG8_LAS unsigned char*)F.lds, g, S, E);
}

#if defined(__HIP_DEVICE_COMPILE__)
typedef const __attribute__((address_space(4))) Args* ArgsP;
DI Args load_args(ArgsP p) { asm volatile("" : "+s"(p)); Args r; const __attribute__((address_space(4))) unsigned long long* q = (const __attribute__((address_space(4))) unsigned long long*)p; unsigned long long* d = (unsigned long long*)&r;
#pragma unroll
    for (int i = 0; i < (int)(sizeof(Args) / 8); ++i) d[i] = q[i];
    return r; }
#define KERNARG_PTR() ((ArgsP)__builtin_amdgcn_kernarg_segment_ptr())
#else
typedef const Args* ArgsP;
__host__ __device__ static inline Args load_args(ArgsP p) { return *p; }
#define KERNARG_PTR() ((ArgsP)nullptr)
#endif
#define LOADARGS() const Args a = load_args(ap0); unsigned char* const ws = a.ws; bf16* const Wb = (bf16*)(ws + WS_W); bf16* const H = (bf16*)(ws + WS_H); bf16* const ACT = (bf16*)(ws + WS_ACT); bf16* const Y = (bf16*)(ws + WS_Y); float* const X = a.out; \
    const float* const mod = (const float*)(ws + WS_MOD); const float* const ng = a.in[4] + (size_t)l * 6 * DM; const float* const modl = mod + (size_t)l * 4 * NMOD * DM; (void)Wb; (void)H; (void)ACT; (void)Y; (void)X; (void)ng; (void)modl;

#define GSYNC() do { asm volatile("s_waitcnt vmcnt(0) lgkmcnt(0)" ::: "memory"); grid.sync(); __builtin_amdgcn_fence(__ATOMIC_ACQUIRE, "agent"); asm volatile("s_waitcnt vmcnt(0)" ::: "memory"); } while (0)
__global__ void __launch_bounds__(NTHR, 2) fwd_megakernel(Args a_unused) {
    extern __shared__ __attribute__((aligned(16))) unsigned char lds_raw[];
    cg::grid_group grid = cg::this_grid();
    Ctx F; F.tid = threadIdx.x; F.lane = F.tid & 63; F.wave = __builtin_amdgcn_readfirstlane(F.tid >> 6); F.G = gridDim.x; F.bid = blockIdx.x; F.lds = (LAS unsigned char*)lds_raw;
    const ArgsP ap0 = KERNARG_PTR();
    volatile LAS unsigned* bst = (volatile LAS unsigned*)(F.lds + 131072);
    if (F.tid < 2) bst[F.tid] = 0u;
    __syncthreads();
    { const Args a0 = load_args(ap0); (void)xcd_barrier_post((unsigned*)(a0.ws + WS_BAR), bst); }
#define XSYNC() do { const Args a_ = load_args(ap0); XcdBarrier xb_; xb_.bar = (unsigned*)(a_.ws + WS_BAR); xb_.x = xb_xcc_id(); xb_.st = (volatile LAS unsigned*)(F.lds + 131072); xcd_barrier(xb_); } while (0)

    { const int l = 0; LOADARGS();
      build_tables(F, a);
      compute_mod(F, a);
      convert_weights(F, a, 0); }
    GSYNC();
    { const int l = 0; LOADARGS();
      rowwise(F, a.in[0], nullptr, 0.f, nullptr, nullptr, X, a.in[4], mod + 0 * DM, mod + 1 * DM, H, false, true); }
    XSYNC();

#pragma unroll 1
    for (int l = 0; l < DEPTH; ++l) {
#pragma unroll 1
        for (int half = 0; half < 2; ++half) {
            { LOADARGS(); pg8::EpiSwiglu E{ACT, DFF}; run_gemm(F, H, Wb + (half * W_FFN_STRIDE + W_FFN_IN) / 2, T, 2 * DFF, DM, E); }
            XSYNC();
            { LOADARGS(); pg8::EpiPlain E{Y, DM}; run_gemm(F, ACT, Wb + (half * W_FFN_STRIDE + W_FFN_OUT) / 2, T, DM, DFF, E); }
            XSYNC();
            { LOADARGS();
              if (half == 0) rowwise(F, X, Y, 0.5f, modl + 2 * DM, ng + 1 * DM, X, ng + 2 * DM, modl + 3 * DM, modl + 4 * DM, H, true, true);
              else {
                const bool nxt = (l + 1 < DEPTH);
                rowwise(F, X, Y, 0.5f, modl + 8 * DM, ng + 5 * DM, X, ng + 6 * DM, modl + 4 * NMOD * DM, modl + 4 * NMOD * DM + DM, H, true, nxt);
                if (nxt) convert_weights(F, a, l + 1);
              } }
            XSYNC();
            if (half == 0) {
                { LOADARGS(); pg8::EpiMixA E{(bf16*)(ws + WS_ZA), (bf16*)(ws + WS_U), (bf16*)(ws + WS_ZC), (bf16*)(ws + WS_ZD)}; run_gemm(F, H, Wb + W_MIXIN / 2, T, 2048, DM, E); }
                XSYNC();
                { LOADARGS(); mixer_pre(F, a, l); }
                XSYNC();
                { LOADARGS(); pg8::EpiDftC E{(bf16*)(ws + WS_ZT)}; run_gemm(F, (const bf16*)(ws + WS_WDFTC), (const bf16*)(ws + WS_ZD), 256, T * 4, 128, E); }
                { LOADARGS(); pg8::EpiQ E{(bf16*)(ws + WS_Q), (const float*)(ws + WS_COS), (const float*)(ws + WS_SIN), C2}; run_gemm(F, (const bf16*)(ws + WS_CQN), Wb + W_UQ / 2, T, 768, QLP, E); }
                { LOADARGS(); pg8::EpiK E{(bf16*)(ws + WS_KN)}; run_gemm(F, (const bf16*)(ws + WS_CKVN), Wb + W_UKV / 2, T, 512, KVL, E); }
                { LOADARGS(); pg8::EpiVt E{(bf16*)(ws + WS_VT)}; run_gemm(F, Wb + W_UKV / 2 + 512 * KVL, (const bf16*)(ws + WS_CKVN), 512, T, KVL, E); }
                XSYNC();
                { LOADARGS(); pg8::EpiFftA E{(bf16*)(ws + WS_YP), (const pg8::f32x2_t*)(ws + WS_TW)}; run_gemm(F, (const bf16*)(ws + WS_WFFTA), (const bf16*)(ws + WS_ZT), 256, T * 4, 256, E); }
                { LOADARGS(); attn_phase(F, (const bf16*)(ws + WS_Q), (const bf16*)(ws + WS_KN), (const bf16*)(ws + WS_KR), (const bf16*)(ws + WS_VT), (bf16*)(ws + WS_O)); }
                XSYNC();
                { LOADARGS(); pg8::EpiFftC E{(bf16*)(ws + WS_F)}; run_gemm(F, (const bf16*)(ws + WS_W64), (const bf16*)(ws + WS_YP), 256, T * 8, 128, E); }
                XSYNC();
                { LOADARGS(); pg8::EpiSigm E{(bf16*)(ws + WS_GATES), 4096}; run_gemm(F, H, Wb + W_MIXIN / 2 + (size_t)2048 * DM, T, 4096, DM, E); }
                XSYNC();
#pragma unroll 1
                for (int br = 0; br < 4; ++br) { LOADARGS();
                    const bf16* A = br == 0 ? (const bf16*)(ws + WS_O) : br == 1 ? (const bf16*)(ws + WS_YB) : br == 2 ? (const bf16*)(ws + WS_DP) : (const bf16*)(ws + WS_F);
                    const bf16* B = br == 0 ? Wb + W_A / 2 : br == 1 ? Wb + W_B / 2 : br == 2 ? Wb + W_C / 2 : Wb + W_D / 2;
                    pg8::EpiMerge E{H, (const bf16*)(ws + WS_GATES), br}; run_gemm(F, A, B, T, DM, br == 1 ? 256 : 512, E);
                }
                XSYNC();
                { LOADARGS(); pg8::EpiPlain E{Y, DM}; run_gemm(F, H, Wb + W_OUT / 2, T, DM, DM, E); }
                XSYNC();
                { LOADARGS(); rowwise(F, X, Y, 1.0f, modl + 5 * DM, ng + 3 * DM, X, ng + 4 * DM, modl + 6 * DM, modl + 7 * DM, H, true, true); }
                XSYNC();
            }
        }
    }
}

extern "C" void kernel_launch(void* const* d_in, const int* in_sizes, int n_in, void* d_out, int out_size, void* d_ws, size_t ws_size, hipStream_t stream) {
    static int grid = 0;
    if (grid == 0) {
        int dev = 0, cus = 0, per_cu = 0;
        hipGetDevice(&dev); hipDeviceGetAttribute(&cus, hipDeviceAttributeMultiprocessorCount, dev);
        hipFuncSetAttribute((const void*)fwd_megakernel, hipFuncAttributeMaxDynamicSharedMemorySize, LDS_BYTES);
        hipOccupancyMaxActiveBlocksPerMultiprocessor(&per_cu, (const void*)fwd_megakernel, NTHR, LDS_BYTES);
        (void)hipGetLastError();
        if (n_in != 25 || ws_size < WS_END || per_cu < 1) { fprintf(stderr, "kernel_launch: unexpected config n_in %d ws %zu per_cu %d\n", n_in, ws_size, per_cu); if (per_cu < 1) per_cu = 1; }
        grid = cus > 0 ? cus : 256;
    }
    (void)hipMemsetAsync((char*)d_ws + WS_BAR, 0, BAR_ZERO_BYTES, stream);
    Args a{};
    for (int i = 0; i < 25; ++i) a.in[i] = (const float*)d_in[i];
    a.out = (float*)d_out; a.ws = (unsigned char*)d_ws;
    void* args[] = {&a};
    hipError_t e = hipLaunchCooperativeKernel((const void*)fwd_megakernel, dim3(grid), dim3(NTHR), args, LDS_BYTES, stream);
    if (e != hipSuccess) fprintf(stderr, "cooperative launch failed: %s (grid %d)\n", hipGetErrorString(e), grid);
}
```
